# Optimizing an MI355X kernel written in HIP

```python
import jax, jax.numpy as jnp
from jax import lax
import numpy as np


D_MODEL = 1024
BATCH = 32
SEQ = 2048
DEPTH = 1

CHUNK = 64
N_META = 16
CONV_WIDTH = D_MODEL
CONV_K = 3
SB_HEADS = 16
SB_HEAD_DIM = 64
SB_WIDTH = SB_HEADS * SB_HEAD_DIM
N_BRANCH = 2
D_FF = -(-8 * D_MODEL // (3 * 256)) * 256
Q_BLOCK = 128
EPS = 1e-6
SPLITS = (CONV_WIDTH, 2 * CONV_WIDTH, 3 * CONV_WIDTH,
          3 * CONV_WIDTH + SB_WIDTH, 3 * CONV_WIDTH + 2 * SB_WIDTH, 3 * CONV_WIDTH + 3 * SB_WIDTH)
IN_COLS = 3 * CONV_WIDTH + 3 * SB_WIDTH + N_BRANCH * D_MODEL

kernel_name = "hybrid_shortconv_stickbreaking_gated_block"


def rmsnorm(x, g):
    xf = x.astype(jnp.float32)
    y = xf * lax.rsqrt(jnp.mean(xf * xf, axis=-1, keepdims=True) + EPS)
    return (y * g.astype(jnp.float32)).astype(x.dtype)


def short_conv(u, w):
    c = u.shape[-1]
    return lax.conv_general_dilated(
        u, w[:, None, :].astype(u.dtype), window_strides=(1,),
        padding=[(CONV_K - 1, 0)],
        dimension_numbers=('NWC', 'WIO', 'NWC'),
        feature_group_count=c)


def stick_breaking(q, k, v):
    lp = q.shape[2]
    scale = SB_HEAD_DIM ** -0.5
    outs = []
    for i in range(lp // Q_BLOCK):
        q0 = i * Q_BLOCK
        kend = q0 + Q_BLOCK
        qb = q[:, :, q0:kend].astype(jnp.float32)
        kb = k[:, :, :kend].astype(jnp.float32)
        vb = v[:, :, :kend].astype(jnp.float32)
        z = jnp.einsum('bhqd,bhkd->bhqk', qb, kb) * scale
        t_idx = q0 + jnp.arange(Q_BLOCK)[:, None]
        s_idx = jnp.arange(kend)[None, :]
        causal = s_idx < t_idx
        log_beta = jax.nn.log_sigmoid(z)
        log_1m_beta = jnp.where(causal, log_beta - z, 0.0)
        after = lax.cumsum(log_1m_beta, axis=3, reverse=True) - log_1m_beta
        a = jnp.where(causal, jnp.exp(log_beta + after), 0.0)
        outs.append(jnp.einsum('bhqk,bhkd->bhqd', a, vb))
    return jnp.concatenate(outs, axis=2).astype(v.dtype)


def setup_inputs(seed: int = 0) -> dict:
    key = jax.random.key(seed)
    ks = jax.random.split(key, 16)
    nrm = jax.random.normal
    x = nrm(ks[0], (BATCH, SEQ, D_MODEL), jnp.float32)
    meta_tokens = nrm(ks[1], (N_META, D_MODEL), jnp.float32)
    norm1_g = 1.0 + 0.02 * nrm(ks[2], (DEPTH, D_MODEL), jnp.float32)
    w_in = nrm(ks[3], (DEPTH, D_MODEL, IN_COLS), jnp.float32) * D_MODEL ** -0.5
    b_gate = 0.02 * nrm(ks[4], (DEPTH, N_BRANCH * D_MODEL), jnp.float32)
    conv_w = nrm(ks[5], (DEPTH, CONV_K, CONV_WIDTH), jnp.float32) * CONV_K ** -0.5
    w_conv_out = nrm(ks[6], (DEPTH, CONV_WIDTH, D_MODEL), jnp.float32) * CONV_WIDTH ** -0.5
    q_norm_g = 1.0 + 0.02 * nrm(ks[7], (DEPTH, SB_HEAD_DIM), jnp.float32)
    k_norm_g = 1.0 + 0.02 * nrm(ks[8], (DEPTH, SB_HEAD_DIM), jnp.float32)
    w_sb_out = nrm(ks[9], (DEPTH, SB_WIDTH, D_MODEL), jnp.float32) * SB_WIDTH ** -0.5
    w_o = nrm(ks[10], (DEPTH, D_MODEL, D_MODEL), jnp.float32) * D_MODEL ** -0.5
    norm2_g = 1.0 + 0.02 * nrm(ks[11], (DEPTH, D_MODEL), jnp.float32)
    w_ffn_in = nrm(ks[12], (DEPTH, D_MODEL, 2 * D_FF), jnp.float32) * D_MODEL ** -0.5
    w_ffn_out = nrm(ks[13], (DEPTH, D_FF, D_MODEL), jnp.float32) * D_FF ** -0.5
    return {"x": x, "meta_tokens": meta_tokens, "norm1_g": norm1_g, "w_in": w_in,
            "b_gate": b_gate, "conv_w": conv_w, "w_conv_out": w_conv_out,
            "q_norm_g": q_norm_g, "k_norm_g": k_norm_g, "w_sb_out": w_sb_out,
            "w_o": w_o, "norm2_g": norm2_g, "w_ffn_in": w_ffn_in, "w_ffn_out": w_ffn_out}


def reference(x, meta_tokens, norm1_g, w_in, b_gate, conv_w, w_conv_out,
              q_norm_g, k_norm_g, w_sb_out, w_o, norm2_g, w_ffn_in, w_ffn_out):
    bsz = x.shape[0]
    meta = jnp.broadcast_to(meta_tokens[None].astype(x.dtype), (bsz, N_META, x.shape[-1]))
    h = jnp.concatenate([meta, x], axis=1)
    seq_len = h.shape[1]
    pad = (-seq_len) % Q_BLOCK
    for l in range(DEPTH):
        n = rmsnorm(h, norm1_g[l])
        proj = n @ w_in[l]
        xb, xc, xu, q, k, v, g = jnp.split(proj, SPLITS, axis=-1)

        y_conv = (xb * short_conv(xc * xu, conv_w[l])) @ w_conv_out[l]

        def heads(t, gain):
            t = t.reshape(bsz, seq_len, SB_HEADS, SB_HEAD_DIM)
            if gain is not None:
                t = rmsnorm(t, gain)
            t = jnp.transpose(t, (0, 2, 1, 3))
            return jnp.pad(t, ((0, 0), (0, 0), (0, pad), (0, 0)))
        o = stick_breaking(heads(q, q_norm_g[l]), heads(k, k_norm_g[l]), heads(v, None))
        o = jnp.transpose(o[:, :, :seq_len], (0, 2, 1, 3)).reshape(bsz, seq_len, SB_WIDTH)
        y_sb = o @ w_sb_out[l]

        gates = jax.nn.sigmoid(g + b_gate[l]).reshape(bsz, seq_len, N_BRANCH, -1)
        merged = gates[:, :, 0] * y_conv + gates[:, :, 1] * y_sb
        h = h + merged @ w_o[l]

        n2 = rmsnorm(h, norm2_g[l])
        gate, up = jnp.split(n2 @ w_ffn_in[l], 2, axis=-1)
        h = h + (jax.nn.silu(gate) * up) @ w_ffn_out[l]
    return h[:, N_META:]
```

```cpp
#include <hip/hip_runtime.h>
#include <hip/hip_cooperative_groups.h>
#include <cstdio>
#include <cstdint>
namespace cg = cooperative_groups;

#ifndef MK_N_LAUNCHES
#define MK_N_LAUNCHES 1
#endif

#define LAS __attribute__((address_space(3)))
typedef unsigned short bf16_t;
typedef short bf16x8 __attribute__((ext_vector_type(8)));
typedef float f32x4 __attribute__((ext_vector_type(4)));
typedef float f32x16 __attribute__((ext_vector_type(16)));
typedef unsigned u32x4 __attribute__((ext_vector_type(4)));
typedef unsigned u32x2 __attribute__((ext_vector_type(2)));

constexpr int DM = 1024, NB = 32, SEQ = 2048, NMETA = 16, LTOK = SEQ + NMETA;
constexpr int MFULL = NB * LTOK;
constexpr int MC = NB * SEQ;
constexpr int NIN = 8192, DFF = 2816, NFF2 = 2 * DFF;
constexpr float EPS = 1e-6f;
constexpr float LOG2E = 1.4426950408889634f;
constexpr float C2 = 0.125f * LOG2E;

constexpr size_t MiB = 1u << 20;
constexpr size_t WS_RINV = 0;
constexpr size_t WS_SSQ = 512 * 1024;
constexpr size_t WS_WIN = 1 * MiB;
constexpr size_t WS_WC = 17 * MiB, WS_WS = 19 * MiB, WS_WO = 21 * MiB;
constexpr size_t WS_WFI = 23 * MiB;
constexpr size_t WS_WFO = 34 * MiB;
constexpr size_t WS_XB = 40 * MiB, WS_CU = 169 * MiB, WS_Q = 298 * MiB, WS_K = 427 * MiB, WS_V = 556 * MiB;
constexpr size_t WS_G = 685 * MiB;
constexpr size_t WS_END = 943 * MiB;
constexpr size_t WS_T = WS_Q, WS_MM = WS_K, WS_H1B = WS_V;
constexpr size_t WS_ACT = WS_XB;
constexpr size_t OUT_U = 0, OUT_O = 128 * MiB;

namespace pg8 {
constexpr int BM = 256, BK = 64, HALF = 128, HTB = HALF * BK * 2, STAGE_BYTES = 8 * HTB, NXCD = 8, WGM = 8;
__host__ __device__ __forceinline__ int lds_byte(int r, int c) { const int st = (r >> 4) * 2 + (c >> 5), rr = r & 15, cc = c & 31, ob = rr * 64 + cc * 2; return st * 1024 + (ob ^ (((ob >> 9) & 1) << 5)); }
__host__ __device__ __forceinline__ void stage_rc(int b, int& R, int& C) { const int st = b / 1024, sb = b % 1024, swz = sb ^ (((sb >> 9) & 1) << 5); R = (st >> 1) * 16 + swz / 64; C = (st & 1) * 32 + (swz % 64) / 2; }
__host__ __device__ __forceinline__ int perm32(int rho) { const int n = rho >> 4, i = rho & 15; return 8 * (i >> 2) + 4 * n + (i & 3); }

struct Unit { int pm, pn; };
struct Gemm { const bf16_t* A; const bf16_t* Bt; int M, N, K; };

struct StaticOrder {
    int nM, nN, nwg, G, c;
    __host__ __device__ void init(int M, int N, int G_, int c_) { nM = M / BM; nN = N / BM; nwg = nM * nN; G = G_; c = c_; }
    __host__ __device__ bool next(int i, Unit& u) const {
        const long L = (long)i * G + c; if (L >= nwg) return false;
        int wgid = (int)L; { const int q = nwg / NXCD, r = nwg % NXCD, xcd = wgid % NXCD, off = wgid / NXCD; wgid = (xcd < r ? xcd * (q + 1) : r * (q + 1) + (xcd - r) * q) + off; }
        const int nig = WGM * nN, gid = wgid / nig, fm = gid * WGM, gsz = (nM - fm) < WGM ? (nM - fm) : WGM;
        u.pm = fm + ((wgid % nig) % gsz); u.pn = (wgid % nig) / gsz; return true;
    }
};

typedef float f32x2_t __attribute__((ext_vector_type(2))); typedef __bf16 bf16x2_t __attribute__((ext_vector_type(2)));
__device__ __forceinline__ unsigned cvt_pk_bf16(float lo, float hi) { const f32x2_t v = {lo, hi}; const bf16x2_t b = __builtin_convertvector(v, bf16x2_t); return __builtin_bit_cast(unsigned, b); }
__device__ __forceinline__ u32x4 pack8(const f32x4 a, const f32x4 b) { u32x4 w; w.x = cvt_pk_bf16(a[0], a[1]); w.y = cvt_pk_bf16(a[2], a[3]); w.z = cvt_pk_bf16(b[0], b[1]); w.w = cvt_pk_bf16(b[2], b[3]); return w; }
__device__ __forceinline__ void unpack8(const u32x4 w, f32x4& a, f32x4& b) {
    a[0] = __uint_as_float(w.x << 16); a[1] = __uint_as_float(w.x & 0xffff0000u); a[2] = __uint_as_float(w.y << 16); a[3] = __uint_as_float(w.y & 0xffff0000u);
    b[0] = __uint_as_float(w.z << 16); b[1] = __uint_as_float(w.z & 0xffff0000u); b[2] = __uint_as_float(w.w << 16); b[3] = __uint_as_float(w.w & 0xffff0000u);
}
__device__ __forceinline__ float sigmoidf_fast(float x) { return __builtin_amdgcn_rcpf(1.0f + __builtin_amdgcn_exp2f(-LOG2E * x)); }

struct EpiP1 {
    static constexpr bool PERM = true, AFTER_DRAIN = false;
    const float* rinv; bf16_t *XB, *CU, *Q, *K, *V, *G; const float *gq, *gk, *bg;
    __device__ __forceinline__ void operator()(const f32x4 (&acc)[2][2][4][2], const Unit& u, int wr, int wc, int fr, int fq) const {
        const int row0 = u.pm * BM + wr * 64 + fr; const int pn = u.pn;
        if (pn < 4 || (pn >= 20 && pn < 24)) {
            bf16_t* base = (pn < 4 ? XB : V) + (pn & 3) * 256 + wc * 32 + 8 * fq;
#pragma unroll
            for (int ai = 0; ai < 2; ++ai)
#pragma unroll
                for (int m = 0; m < 4; ++m) { const int row = row0 + ai * HALF + m * 16; const float ri = rinv[row]; bf16_t* rowp = base + (size_t)row * DM;
#pragma unroll
                    for (int bj = 0; bj < 2; ++bj) *(u32x4*)(rowp + bj * HALF) = pack8(acc[ai][bj][m][0] * ri, acc[ai][bj][m][1] * ri); }
        } else if (pn < 12) {
            bf16_t* base = CU + (pn - 4) * 128 + wc * 32 + 8 * fq;
#pragma unroll
            for (int ai = 0; ai < 2; ++ai)
#pragma unroll
                for (int m = 0; m < 4; ++m) { const int row = row0 + ai * HALF + m * 16; const float ri = rinv[row]; const float r2 = ri * ri;
                    *(u32x4*)(base + (size_t)row * DM) = pack8(acc[ai][0][m][0] * acc[ai][1][m][0] * r2, acc[ai][0][m][1] * acc[ai][1][m][1] * r2); }
        } else if (pn < 20) {
            const bool isq = pn < 16; const int head = ((pn - 12) & 3) * 4 + wc; bf16_t* base = (isq ? Q : K) + head * 64 + 8 * fq; const float* gp = (isq ? gq : gk) + 8 * fq; const float post = isq ? C2 : 1.0f;
            f32x4 gv[2][2];
#pragma unroll
            for (int bj = 0; bj < 2; ++bj)
#pragma unroll
                for (int n = 0; n < 2; ++n) gv[bj][n] = *(const f32x4*)(gp + 32 * bj + 4 * n);
#pragma unroll
            for (int ai = 0; ai < 2; ++ai)
#pragma unroll
                for (int m = 0; m < 4; ++m) { const int row = row0 + ai * HALF + m * 16; const float ri = rinv[row]; float ss = 0.f;
#pragma unroll
                    for (int bj = 0; bj < 2; ++bj)
#pragma unroll
                        for (int n = 0; n < 2; ++n) { const f32x4 x = acc[ai][bj][m][n]; ss += (x[0] * x[0] + x[1] * x[1]) + (x[2] * x[2] + x[3] * x[3]); }
                    ss += __shfl_xor(ss, 16); ss += __shfl_xor(ss, 32);
                    const float rr = __builtin_amdgcn_rsqf(ss * (ri * ri) * (1.0f / 64.0f) + EPS) * ri * post;
#pragma unroll
                    for (int bj = 0; bj < 2; ++bj) *(u32x4*)(base + (size_t)row * DM + 32 * bj) = pack8(acc[ai][bj][m][0] * rr * gv[bj][0], acc[ai][bj][m][1] * rr * gv[bj][1]); }
        } else {
            const int col0 = (pn - 24) * 256 + wc * 32 + 8 * fq; bf16_t* base = G + col0;
            f32x4 bv[2][2];
#pragma unroll
            for (int bj = 0; bj < 2; ++bj)
#pragma unroll
                for (int n = 0; n < 2; ++n) bv[bj][n] = *(const f32x4*)(bg + col0 + bj * HALF + 4 * n);
#pragma unroll
            for (int ai = 0; ai < 2; ++ai)
#pragma unroll
                for (int m = 0; m < 4; ++m) { const int row = row0 + ai * HALF + m * 16; const float ri = rinv[row];
#pragma unroll
                    for (int bj = 0; bj < 2; ++bj) { f32x4 a = acc[ai][bj][m][0] * ri + bv[bj][0], b = acc[ai][bj][m][1] * ri + bv[bj][1];
#pragma unroll
                        for (int i = 0; i < 4; ++i) { a[i] = sigmoidf_fast(a[i]); b[i] = sigmoidf_fast(b[i]); }
                        *(u32x4*)(base + (size_t)row * 2048 + bj * HALF) = pack8(a, b); } }
        }
    }
};
template <int SECOND> struct EpiGate {
    static constexpr bool PERM = true, AFTER_DRAIN = false;
    const bf16_t* G; bf16_t* T; bf16_t* MMo;
    __device__ __forceinline__ void operator()(const f32x4 (&acc)[2][2][4][2], const Unit& u, int wr, int wc, int fr, int fq) const {
        const int row0 = u.pm * BM + wr * 64 + fr; const int goff = ((u.pm >> 3) + 1) * NMETA; const int col0 = u.pn * BM + wc * 32 + 8 * fq;
#pragma unroll
        for (int ai = 0; ai < 2; ++ai)
#pragma unroll
            for (int m = 0; m < 4; ++m) { const int row = row0 + ai * HALF + m * 16;
#pragma unroll
                for (int bj = 0; bj < 2; ++bj) { const int col = col0 + bj * HALF;
                    f32x4 g0, g1; unpack8(*(const u32x4*)(G + (size_t)(row + goff) * 2048 + SECOND * 1024 + col), g0, g1);
                    f32x4 a = acc[ai][bj][m][0] * g0, b = acc[ai][bj][m][1] * g1;
                    if (SECOND) { f32x4 t0, t1; unpack8(*(const u32x4*)(T + (size_t)row * DM + col), t0, t1); a += t0; b += t1; *(u32x4*)(MMo + (size_t)row * DM + col) = pack8(a, b); }
                    else *(u32x4*)(T + (size_t)row * DM + col) = pack8(a, b); } }
    }
};
struct EpiH1 {
    static constexpr bool PERM = true, AFTER_DRAIN = false;
    const float* x; float* out; bf16_t* H1B; float* ssq;
    __device__ __forceinline__ void operator()(const f32x4 (&acc)[2][2][4][2], const Unit& u, int wr, int wc, int fr, int fq) const {
        const int row0 = u.pm * BM + wr * 64 + fr; const int col0 = u.pn * BM + wc * 32 + 8 * fq;
#pragma unroll
        for (int ai = 0; ai < 2; ++ai)
#pragma unroll
            for (int m = 0; m < 4; ++m) { const int row = row0 + ai * HALF + m * 16; float ss = 0.f;
#pragma unroll
                for (int bj = 0; bj < 2; ++bj) { const size_t off = (size_t)row * DM + col0 + bj * HALF;
                    const f32x4 a = *(const f32x4*)(x + off) + acc[ai][bj][m][0], b = *(const f32x4*)(x + off + 4) + acc[ai][bj][m][1];
                    *(f32x4*)(out + off) = a; *(f32x4*)(out + off + 4) = b; *(u32x4*)(H1B + off) = pack8(a, b);
                    ss += (a[0] * a[0] + a[1] * a[1]) + (a[2] * a[2] + a[3] * a[3]) + (b[0] * b[0] + b[1] * b[1]) + (b[2] * b[2] + b[3] * b[3]); }
                ss += __shfl_xor(ss, 16); ss += __shfl_xor(ss, 32);
                if (fq == 0) atomicAdd(ssq + row, ss); }
    }
};
struct EpiF1 {
    static constexpr bool PERM = true, AFTER_DRAIN = false;
    const float* ssq; bf16_t* ACT;
    __device__ __forceinline__ void operator()(const f32x4 (&acc)[2][2][4][2], const Unit& u, int wr, int wc, int fr, int fq) const {
        const int row0 = u.pm * BM + wr * 64 + fr; const int col0 = u.pn * 128 + wc * 32 + 8 * fq;
#pragma unroll
        for (int ai = 0; ai < 2; ++ai)
#pragma unroll
            for (int m = 0; m < 4; ++m) { const int row = row0 + ai * HALF + m * 16; const float ri = __builtin_amdgcn_rsqf(ssq[row] * (1.0f / DM) + EPS);
                f32x4 o[2];
#pragma unroll
                for (int n = 0; n < 2; ++n) { const f32x4 g = acc[ai][0][m][n] * ri, up = acc[ai][1][m][n] * ri;
#pragma unroll
                    for (int i = 0; i < 4; ++i) o[n][i] = g[i] * sigmoidf_fast(g[i]) * up[i]; }
                *(u32x4*)(ACT + (size_t)row * DFF + col0) = pack8(o[0], o[1]); }
    }
};
struct EpiOut {
    static constexpr bool PERM = true, AFTER_DRAIN = false;
    float* out;
    __device__ __forceinline__ void operator()(const f32x4 (&acc)[2][2][4][2], const Unit& u, int wr, int wc, int fr, int fq) const {
        const int row0 = u.pm * BM + wr * 64 + fr; const int col0 = u.pn * BM + wc * 32 + 8 * fq;
#pragma unroll
        for (int ai = 0; ai < 2; ++ai)
#pragma unroll
            for (int m = 0; m < 4; ++m) { const int row = row0 + ai * HALF + m * 16;
#pragma unroll
                for (int bj = 0; bj < 2; ++bj) { const size_t off = (size_t)row * DM + col0 + bj * HALF;
                    const f32x4 a = *(const f32x4*)(out + off) + acc[ai][bj][m][0], b = *(const f32x4*)(out + off + 4) + acc[ai][bj][m][1];
                    *(f32x4*)(out + off) = a; *(f32x4*)(out + off + 4) = b; } }
    }
};

template <class Epi, class Sched, bool ALIGN_EPI = false, bool SP2 = false>
__device__ __forceinline__ void gemm_phase(LAS unsigned char* lds, const Gemm g, const Sched& S, const Epi& E) {
    const int tid = threadIdx.x, wid = __builtin_amdgcn_readfirstlane(tid >> 6), lane = tid & 63, wr = wid >> 2, wc = wid & 3, fr = lane & 15, fq = lane >> 4;
    const int K = g.K, nt = K / BK;
    unsigned voffA[2], voffB[2];
#pragma unroll
    for (int i = 0; i < 2; ++i) { int R, C; stage_rc(tid * 16 + i * 8192, R, C); const int Rb = Epi::PERM ? ((R & ~31) + perm32(R & 31)) : R;
        voffA[i] = (unsigned)(R * K + C) * 2u; voffB[i] = (unsigned)(Rb * K + C) * 2u; }
    const size_t kstep = (size_t)(BK * 2);
    const size_t hstep = (size_t)HALF * K * 2;
    const size_t tstep = 2 * hstep;
    const unsigned ldsw = (unsigned)wid * 1024u;
    const int aoff = lds_byte(wr * 64 + fr, fq * 8), boff = lds_byte(wc * 32 + fr, fq * 8);
#define PG8_SA(b, h) (((b) * 2 + (h)) * HTB)
#define PG8_SB(b, h) ((4 + (b) * 2 + (h)) * HTB)
#define PG8_STAGE(bufoff, gbase, voff) do { _Pragma("unroll") for (int _i = 0; _i < 2; ++_i) \
        __builtin_amdgcn_global_load_lds((const unsigned*)((const char*)(gbase) + (voff)[_i]), (LAS unsigned*)(lds + (bufoff) + ldsw + _i * 8192), 16, 0, 0); } while (0)
#define PG8_LDA(dst, b, h) do { _Pragma("unroll") for (int m = 0; m < 4; ++m) _Pragma("unroll") for (int k = 0; k < 2; ++k) dst[m][k] = *(const LAS bf16x8*)(lds + PG8_SA(b, h) + aoff + m * 2048 + k * 1024); } while (0)
#define PG8_LDB(dst, b, h) do { _Pragma("unroll") for (int n = 0; n < 2; ++n) _Pragma("unroll") for (int k = 0; k < 2; ++k) dst[n][k] = *(const LAS bf16x8*)(lds + PG8_SB(b, h) + boff + n * 2048 + k * 1024); } while (0)
#define PG8_MMA(ai, bj, At, Bt) do { __builtin_amdgcn_s_setprio(1); _Pragma("unroll") for (int m = 0; m < 4; ++m) _Pragma("unroll") for (int n = 0; n < 2; ++n) _Pragma("unroll") for (int k = 0; k < 2; ++k) \
        acc[ai][bj][m][n] = __builtin_amdgcn_mfma_f32_16x16x32_bf16(Bt[n][k], At[m][k], acc[ai][bj][m][n], 0, 0, 0); __builtin_amdgcn_s_setprio(0); } while (0)
#define PG8_WAIT_V(n) asm volatile("s_waitcnt vmcnt(" #n ")" ::: "memory")
#define PG8_WAIT_L(n) asm volatile("s_waitcnt lgkmcnt(" #n ")" ::: "memory")
#define PG8_BAR __builtin_amdgcn_s_barrier()
#define PG8_SCHED __builtin_amdgcn_sched_barrier(0)
    Unit cur, nxt; int ui = 0;
    if (!S.next(0, cur)) return;
    f32x4 acc[2][2][4][2];
#pragma unroll
    for (int a = 0; a < 2; ++a)
#pragma unroll
        for (int b = 0; b < 2; ++b)
#pragma unroll
            for (int m = 0; m < 4; ++m)
#pragma unroll
                for (int n = 0; n < 2; ++n) acc[a][b][m][n] = (f32x4){0.f, 0.f, 0.f, 0.f};
    bf16x8 At[4][2], B0[2][2], B1[2][2];
    const char* cA = (const char*)g.A + (size_t)cur.pm * tstep; const char* cB = (const char*)g.Bt + (size_t)cur.pn * tstep;
    if constexpr (SP2) {
        PG8_STAGE(PG8_SB(0, 0), cB, voffB); PG8_STAGE(PG8_SB(0, 1), cB + hstep, voffB); PG8_STAGE(PG8_SA(0, 0), cA, voffA); PG8_STAGE(PG8_SA(0, 1), cA + hstep, voffA);
        if (wr == 1) PG8_BAR;
        PG8_WAIT_V(2); PG8_BAR;
        PG8_STAGE(PG8_SB(1, 0), cB + kstep, voffB); PG8_STAGE(PG8_SA(1, 0), cA + kstep, voffA); PG8_STAGE(PG8_SB(1, 1), cB + hstep + kstep, voffB);
        PG8_WAIT_V(6); PG8_BAR;
    } else {
        PG8_STAGE(PG8_SB(0, 0), cB, voffB); PG8_STAGE(PG8_SA(0, 0), cA, voffA); PG8_STAGE(PG8_SB(0, 1), cB + hstep, voffB); PG8_STAGE(PG8_SA(0, 1), cA + hstep, voffA);
        if (wr == 1) PG8_BAR;
        PG8_WAIT_V(4); PG8_BAR;
        PG8_STAGE(PG8_SB(1, 0), cB + kstep, voffB); PG8_STAGE(PG8_SA(1, 0), cA + kstep, voffA); PG8_STAGE(PG8_SB(1, 1), cB + hstep + kstep, voffB);
        PG8_WAIT_V(6); PG8_BAR;
    }
    for (;;) {
        const bool has_next = S.next(ui + 1, nxt);
        const char* nA = has_next ? (const char*)g.A + (size_t)nxt.pm * tstep : cA; const char* nB = has_next ? (const char*)g.Bt + (size_t)nxt.pn * tstep : cB;
        for (int t = 0; t < nt; t += 2) {
            const bool last = (t == nt - 2);
            const char* a1 = cA + (size_t)(t + 1) * kstep;
            const char* a2 = last ? nA : cA + (size_t)(t + 2) * kstep; const char* b2 = last ? nB : cB + (size_t)(t + 2) * kstep;
            const char* a3 = a2 + kstep; const char* b3 = b2 + kstep;
            if constexpr (SP2) {
            PG8_LDB(B0, 0, 0); PG8_LDB(B1, 0, 1); PG8_SCHED; PG8_LDA(At, 0, 0); PG8_STAGE(PG8_SA(1, 1), a1 + hstep, voffA);
            PG8_WAIT_V(8); PG8_WAIT_L(0); PG8_BAR; PG8_MMA(0, 0, At, B0); PG8_MMA(0, 1, At, B1); PG8_BAR; PG8_SCHED;
            PG8_LDA(At, 0, 1); PG8_STAGE(PG8_SB(0, 0), b2, voffB); PG8_STAGE(PG8_SB(0, 1), b2 + hstep, voffB); PG8_STAGE(PG8_SA(0, 0), a2, voffA);
            PG8_WAIT_V(8); PG8_WAIT_L(0); PG8_BAR; PG8_MMA(1, 0, At, B0); PG8_MMA(1, 1, At, B1); PG8_BAR; PG8_SCHED;
            PG8_LDB(B0, 1, 0); PG8_LDB(B1, 1, 1); PG8_SCHED; PG8_LDA(At, 1, 0); PG8_STAGE(PG8_SA(0, 1), a2 + hstep, voffA);
            PG8_WAIT_V(8); PG8_WAIT_L(0); PG8_BAR; PG8_MMA(0, 0, At, B0); PG8_MMA(0, 1, At, B1); PG8_BAR; PG8_SCHED;
            PG8_LDA(At, 1, 1); PG8_STAGE(PG8_SB(1, 0), b3, voffB); PG8_STAGE(PG8_SB(1, 1), b3 + hstep, voffB); PG8_STAGE(PG8_SA(1, 0), a3, voffA);
            PG8_WAIT_V(8); PG8_WAIT_L(0); PG8_BAR; PG8_MMA(1, 0, At, B0); PG8_MMA(1, 1, At, B1); PG8_BAR; PG8_SCHED;
            } else {
            PG8_LDB(B0, 0, 0); PG8_SCHED; PG8_LDA(At, 0, 0); PG8_STAGE(PG8_SA(1, 1), a1 + hstep, voffA);
            PG8_WAIT_L(8); PG8_BAR; PG8_WAIT_L(0); PG8_MMA(0, 0, At, B0); PG8_BAR; PG8_SCHED;
            PG8_LDB(B1, 0, 1); PG8_STAGE(PG8_SB(0, 0), b2, voffB);
            PG8_BAR; PG8_WAIT_L(0); PG8_MMA(0, 1, At, B1); PG8_BAR;
            PG8_LDA(At, 0, 1); PG8_STAGE(PG8_SA(0, 0), a2, voffA);
            PG8_BAR; PG8_WAIT_L(0); PG8_MMA(1, 0, At, B0); PG8_BAR; PG8_SCHED;
            PG8_STAGE(PG8_SB(0, 1), b2 + hstep, voffB);
            PG8_WAIT_V(6); PG8_BAR; PG8_MMA(1, 1, At, B1); PG8_BAR;
            PG8_LDB(B0, 1, 0); PG8_SCHED; PG8_LDA(At, 1, 0); PG8_STAGE(PG8_SA(0, 1), a2 + hstep, voffA);
            PG8_WAIT_L(8); PG8_BAR; PG8_WAIT_L(0); PG8_MMA(0, 0, At, B0); PG8_BAR; PG8_SCHED;
            PG8_LDB(B1, 1, 1); PG8_STAGE(PG8_SB(1, 0), b3, voffB);
            PG8_BAR; PG8_WAIT_L(0); PG8_MMA(0, 1, At, B1); PG8_BAR;
            PG8_LDA(At, 1, 1); PG8_STAGE(PG8_SA(1, 0), a3, voffA);
            PG8_BAR; PG8_WAIT_L(0); PG8_MMA(1, 0, At, B0); PG8_BAR; PG8_SCHED;
            PG8_STAGE(PG8_SB(1, 1), b3 + hstep, voffB);
            PG8_WAIT_V(6); PG8_BAR; PG8_MMA(1, 1, At, B1); PG8_BAR;
            }
        }
        if constexpr (ALIGN_EPI) { if (wr == 0) PG8_BAR; }
        E(acc, cur, wr, wc, fr, fq);
        if (!has_next) break;
#pragma unroll
        for (int a = 0; a < 2; ++a)
#pragma unroll
            for (int b = 0; b < 2; ++b)
#pragma unroll
                for (int m = 0; m < 4; ++m)
#pragma unroll
                    for (int n = 0; n < 2; ++n) acc[a][b][m][n] = (f32x4){0.f, 0.f, 0.f, 0.f};
        cur = nxt; cA = nA; cB = nB; ++ui;
        if constexpr (ALIGN_EPI) { if (wr == 1) PG8_BAR; }
    }
    PG8_WAIT_V(0);
    if constexpr (!ALIGN_EPI) { if (wr == 0) PG8_BAR; }
    PG8_BAR;
#undef PG8_SA
#undef PG8_SB
#undef PG8_STAGE
#undef PG8_LDA
#undef PG8_LDB
#undef PG8_MMA
#undef PG8_WAIT_V
#undef PG8_WAIT_L
#undef PG8_BAR
#undef PG8_SCHED
}
}

namespace sb {
constexpr int KBUF = 8192, LDS_V0 = 2 * KBUF;
__device__ __forceinline__ unsigned cvtpk(float lo, float hi) { return pg8::cvt_pk_bf16(lo, hi); }
typedef short v4i16_t __attribute__((ext_vector_type(4)));
__device__ __forceinline__ v4i16_t vtr(const LAS unsigned char* p) { return __builtin_amdgcn_ds_read_tr16_b64_v4i16((LAS v4i16_t*)p); }

__device__ __forceinline__ void attn_unit(int b, int h, int j, const bf16_t* __restrict__ Q, const bf16_t* __restrict__ K, const bf16_t* __restrict__ V, bf16_t* __restrict__ O, LAS unsigned char* lds) {
    const int tid = threadIdx.x, lane = tid & 63, r32 = lane & 31, hi = lane >> 5; const int wid = __builtin_amdgcn_readfirstlane(tid >> 6);
    const long rowbase = (long)b * LTOK;
    const int t0 = NMETA + 256 * j + 32 * wid;
    const int c_top = 4 * j + 4, c_hi = (t0 + 30) >> 6;
    bf16x8 qr[4];
    { const bf16_t* Qw = Q + (rowbase + t0 + r32) * DM + h * 64 + hi * 8;
#pragma unroll
      for (int d0 = 0; d0 < 4; ++d0) qr[d0] = *(const bf16x8*)(Qw + d0 * 16); }
    const int vkey = 16 * (wid & 3) + (lane >> 2);
    const bf16_t* kcol = K + h * 64 + wid * 8; const bf16_t* vcol = V + h * 64 + (wid >> 2) * 32 + (lane & 3) * 8;
    const unsigned soff = (unsigned)wid * 1024u + (unsigned)lane * 16u;
    u32x4 kreg, vreg;
#define SB_LOAD(c) do { int kk = (c) * 64 + lane; kk = kk < LTOK ? kk : LTOK - 1; int vk = (c) * 64 + vkey; vk = vk < LTOK ? vk : LTOK - 1; \
        kreg = *(const u32x4*)(kcol + (rowbase + kk) * DM); vreg = *(const u32x4*)(vcol + (rowbase + vk) * DM); } while (0)
#define SB_STORE(buf) do { *(LAS u32x4*)(lds + (buf) * KBUF + soff) = kreg; *(LAS u32x4*)(lds + LDS_V0 + (buf) * KBUF + soff) = vreg; } while (0)
    SB_LOAD(c_top); SB_STORE(0);
    __syncthreads();
    f32x16 o0 = {}, o1 = {}; float carry = 1.0f;
    const int kperm = 16 * ((r32 >> 2) & 1) + (r32 & 3) + 4 * (r32 >> 3);
    const unsigned kfo = (unsigned)hi * 1024u + (unsigned)kperm * 16u;
    const unsigned vfo = (unsigned)LDS_V0 + (unsigned)(2 * hi) * 512u + (unsigned)((lane & 15) >> 2) * 64u + (unsigned)((lane >> 4) & 1) * 32u + (unsigned)(lane & 3) * 8u;
    int buf = 0;
    for (int c = c_top; c >= 0; --c) {
        if (c > 0) SB_LOAD(c - 1);
        if (c <= c_hi) {
            const LAS unsigned char* Kb = lds + buf * KBUF + kfo;
            f32x16 p0 = {}, p1 = {};
#pragma unroll
            for (int d0 = 0; d0 < 4; ++d0) {
                const bf16x8 k0 = *(const LAS bf16x8*)(Kb + d0 * 2048), k1 = *(const LAS bf16x8*)(Kb + d0 * 2048 + 512);
                p0 = __builtin_amdgcn_mfma_f32_32x32x16_bf16(k0, qr[d0], p0, 0, 0, 0);
                p1 = __builtin_amdgcn_mfma_f32_32x32x16_bf16(k1, qr[d0], p1, 0, 0, 0);
            }
            if (c * 64 + 63 >= t0) {
                const int t = t0 + r32, kb = c * 64 + 16 * hi;
#pragma unroll
                for (int r = 0; r < 16; ++r) { if (kb + r >= t) p0[r] = -INFINITY; if (kb + 32 + r >= t) p1[r] = -INFINITY; }
            }
#pragma unroll
            for (int r = 0; r < 16; ++r) { p0[r] = __builtin_amdgcn_rcpf(1.0f + __builtin_amdgcn_exp2f(p0[r])); p1[r] = __builtin_amdgcn_rcpf(1.0f + __builtin_amdgcn_exp2f(p1[r])); }
#pragma unroll
            for (int r = 14; r >= 0; --r) { p0[r] *= p0[r + 1]; p1[r] *= p1[r + 1]; }
            const float T0 = p0[0], T1 = p1[0];
            const auto s0 = __builtin_amdgcn_permlane32_swap(__float_as_uint(T0), __float_as_uint(T0), false, false);
            const auto s1 = __builtin_amdgcn_permlane32_swap(__float_as_uint(T1), __float_as_uint(T1), false, false);
            const float T0lo = __uint_as_float(s0[0]), T0hi = __uint_as_float(s0[1]), T1lo = __uint_as_float(s1[0]), T1hi = __uint_as_float(s1[1]);
            const float cW1 = carry * (T1lo * T1hi);
            const float E1 = hi ? carry : carry * T1hi;
            const float E0 = hi ? cW1 : cW1 * T0hi;
            carry = cW1 * (T0lo * T0hi);
            float a0[16], a1[16];
            { float up0 = E0, up1 = E1;
#pragma unroll
              for (int r = 15; r >= 0; --r) { const float i0 = p0[r] * E0, i1 = p1[r] * E1; a0[r] = up0 - i0; a1[r] = up1 - i1; up0 = i0; up1 = i1; } }
            u32x4 pw0, pw1, pw2, pw3;
            pw0 = (u32x4){cvtpk(a0[0], a0[1]), cvtpk(a0[2], a0[3]), cvtpk(a0[4], a0[5]), cvtpk(a0[6], a0[7])};
            pw1 = (u32x4){cvtpk(a0[8], a0[9]), cvtpk(a0[10], a0[11]), cvtpk(a0[12], a0[13]), cvtpk(a0[14], a0[15])};
            pw2 = (u32x4){cvtpk(a1[0], a1[1]), cvtpk(a1[2], a1[3]), cvtpk(a1[4], a1[5]), cvtpk(a1[6], a1[7])};
            pw3 = (u32x4){cvtpk(a1[8], a1[9]), cvtpk(a1[10], a1[11]), cvtpk(a1[12], a1[13]), cvtpk(a1[14], a1[15])};
            const LAS unsigned char* Vb = lds + buf * KBUF + vfo;
#define SB_PV(ks, PW) do { const int ko = (((ks) >> 1) * 4 + ((ks) & 1)) * 512; \
                { const v4i16_t lo = vtr(Vb + ko), hh = vtr(Vb + ko + 256); const bf16x8 vf = (bf16x8){lo[0], lo[1], lo[2], lo[3], hh[0], hh[1], hh[2], hh[3]}; \
                  o0 = __builtin_amdgcn_mfma_f32_32x32x16_bf16(__builtin_bit_cast(bf16x8, PW), vf, o0, 0, 0, 0); } \
                { const v4i16_t lo = vtr(Vb + 4096 + ko), hh = vtr(Vb + 4096 + ko + 256); const bf16x8 vf = (bf16x8){lo[0], lo[1], lo[2], lo[3], hh[0], hh[1], hh[2], hh[3]}; \
                  o1 = __builtin_amdgcn_mfma_f32_32x32x16_bf16(__builtin_bit_cast(bf16x8, PW), vf, o1, 0, 0, 0); } } while (0)
            SB_PV(0, pw0); SB_PV(1, pw1); SB_PV(2, pw2); SB_PV(3, pw3);
#undef SB_PV
        }
        if (c > 0) SB_STORE(buf ^ 1);
        __syncthreads();
        buf ^= 1;
    }
#undef SB_LOAD
#undef SB_STORE
    bf16_t* Ow = O + ((size_t)b * SEQ + (t0 - NMETA)) * DM + h * 64 + r32;
#pragma unroll
    for (int r = 0; r < 16; ++r) { const int q = (r & 3) + 8 * (r >> 2) + 4 * hi;
        Ow[(size_t)q * DM] = (bf16_t)(cvtpk(o0[r], 0.f) & 0xffffu); Ow[(size_t)q * DM + 32] = (bf16_t)(cvtpk(o1[r], 0.f) & 0xffffu); }
}
}

__device__ __forceinline__ unsigned f2bf(float f) { unsigned u = __builtin_bit_cast(unsigned, f); return (u + 0x7fffu + ((u >> 16) & 1u)) >> 16; }
__device__ __forceinline__ unsigned pk2(float lo, float hi) { return f2bf(lo) | (f2bf(hi) << 16); }
__device__ __forceinline__ float wave_sum(float v) {
#pragma unroll
    for (int o = 1; o < 64; o <<= 1) v += __shfl_xor(v, o);
    return v;
}
__device__ __forceinline__ int map_win(int s) {
    if (s < 1024) return s;
    if (s < 2048) { const int c = s - 1024; return 1024 + (c >> 7) * 256 + (c & 127); }
    if (s < 3072) { const int c = s - 2048; return 1024 + (c >> 7) * 256 + 128 + (c & 127); }
    if (s < 5120) { const int base = s < 4096 ? 3072 : 4096, c = s - base, hh = c >> 6, d = c & 63; return base + (hh >> 2) * 256 + (d >> 5) * 128 + (hh & 3) * 32 + (d & 31); }
    return s;
}
__device__ __forceinline__ int map_wfi(int s) { const int up = s >= DFF, j = up ? s - DFF : s; return (j >> 7) * 256 + up * 128 + (j & 127); }
__device__ __forceinline__ void p0_transpose_item(const float* W, int K, int N, bf16_t* WT, int k0, int n0, int drow0, const float* gain, LAS float* scr, int lane) {
#pragma unroll 8
    for (int i = 0; i < 32; ++i) { const int kk = 2 * i + (lane >> 5); float v = W[(size_t)(k0 + kk) * N + n0 + (lane & 31)]; if (gain) v *= gain[k0 + kk]; scr[kk * 33 + (lane & 31)] = v; }
    asm volatile("s_waitcnt lgkmcnt(0)" ::: "memory");
    const int c = lane & 7;
#pragma unroll
    for (int j = 0; j < 4; ++j) { const int n = (lane >> 3) + 8 * j; const LAS float* s = scr + (8 * c) * 33 + n;
        u32x4 o; o.x = pk2(s[0 * 33], s[1 * 33]); o.y = pk2(s[2 * 33], s[3 * 33]); o.z = pk2(s[4 * 33], s[5 * 33]); o.w = pk2(s[6 * 33], s[7 * 33]);
        *(u32x4*)(WT + (size_t)(drow0 + n) * K + k0 + 8 * c) = o; }
    asm volatile("s_waitcnt lgkmcnt(0)" ::: "memory");
}

struct Args { const float* in[14]; float* out; unsigned char* ws; int ph_lo, ph_hi; };
constexpr int NWAVES = 8, LDS_BYTES = 147456, N_PHASES = 7;

__global__ void __launch_bounds__(NWAVES * 64, 2) fwd_megakernel(Args args) {
    extern __shared__ __attribute__((aligned(16))) unsigned char lds_raw[];
    LAS unsigned char* lds = (LAS unsigned char*)lds_raw;
    cg::grid_group grid = cg::this_grid();
    const int tid = threadIdx.x, lane = tid & 63, wave = __builtin_amdgcn_readfirstlane(tid >> 6);
    const int G = gridDim.x, bx = blockIdx.x;
    const int vcu = (G % 8 == 0) ? (bx % 8) * (G / 8) + bx / 8 : bx;
    unsigned char* ws = args.ws; unsigned char* ob = (unsigned char*)args.out;
    const float* x = args.in[0]; const float* meta = args.in[1]; const float* norm1_g = args.in[2]; const float* w_in = args.in[3]; const float* b_gate = args.in[4];
    const float* conv_w = args.in[5]; const float* w_conv_out = args.in[6]; const float* q_norm_g = args.in[7]; const float* k_norm_g = args.in[8]; const float* w_sb_out = args.in[9];
    const float* w_o = args.in[10]; const float* norm2_g = args.in[11]; const float* w_ffn_in = args.in[12]; const float* w_ffn_out = args.in[13];
    float* RINV = (float*)(ws + WS_RINV); float* SSQ = (float*)(ws + WS_SSQ);
    bf16_t* WIN = (bf16_t*)(ws + WS_WIN); bf16_t* WC = (bf16_t*)(ws + WS_WC); bf16_t* WSB = (bf16_t*)(ws + WS_WS); bf16_t* WO = (bf16_t*)(ws + WS_WO);
    bf16_t* WFI = (bf16_t*)(ws + WS_WFI); bf16_t* WFO = (bf16_t*)(ws + WS_WFO);
    bf16_t* XB = (bf16_t*)(ws + WS_XB); bf16_t* CU = (bf16_t*)(ws + WS_CU); bf16_t* Qb = (bf16_t*)(ws + WS_Q); bf16_t* Kb = (bf16_t*)(ws + WS_K); bf16_t* Vb = (bf16_t*)(ws + WS_V);
    bf16_t* Gb = (bf16_t*)(ws + WS_G); bf16_t* Tb = (bf16_t*)(ws + WS_T); bf16_t* MMb = (bf16_t*)(ws + WS_MM); bf16_t* H1B = (bf16_t*)(ws + WS_H1B); bf16_t* ACT = (bf16_t*)(ws + WS_ACT);
    bf16_t* HB = (bf16_t*)ob; bf16_t* Ub = (bf16_t*)(ob + OUT_U); bf16_t* Ob = (bf16_t*)(ob + OUT_O);
    const int lo = args.ph_lo, hi = args.ph_hi;
#define IN(k) (lo <= (k) && (k) < hi)
#define SEAM(k) do { if (IN(k) && IN((k) + 1)) grid.sync(); } while (0)

    if (IN(0)) {
        LAS float* scr = (LAS float*)(lds + wave * 16384);
        const int gw = vcu * NWAVES + wave, NGW = G * NWAVES;
        constexpr int I_IN = 16 * (NIN / 32), I_SQ = 16 * 32, I_FI = 16 * (NFF2 / 32), I_FO = (DFF / 64) * 32;
        constexpr int NITEMS = I_IN + 3 * I_SQ + I_FI + I_FO;
        for (int it = gw; it < NITEMS; it += NGW) {
            int r = it;
            if (r < I_IN) { const int nblk = NIN / 32, kb = r / nblk, nb = r % nblk; p0_transpose_item(w_in, DM, NIN, WIN, 64 * kb, 32 * nb, map_win(32 * nb), norm1_g, scr, lane); continue; } r -= I_IN;
            if (r < 3 * I_SQ) { const int w = r / I_SQ, rr = r % I_SQ, kb = rr / 32, nb = rr % 32; const float* W = w == 0 ? w_conv_out : (w == 1 ? w_sb_out : w_o); bf16_t* WT = w == 0 ? WC : (w == 1 ? WSB : WO);
                p0_transpose_item(W, DM, DM, WT, 64 * kb, 32 * nb, 32 * nb, nullptr, scr, lane); continue; } r -= 3 * I_SQ;
            if (r < I_FI) { const int nblk = NFF2 / 32, kb = r / nblk, nb = r % nblk; p0_transpose_item(w_ffn_in, DM, NFF2, WFI, 64 * kb, 32 * nb, map_wfi(32 * nb), norm2_g, scr, lane); continue; } r -= I_FI;
            { const int kb = r / 32, nb = r % 32; p0_transpose_item(w_ffn_out, DFF, DM, WFO, 64 * kb, 32 * nb, 32 * nb, nullptr, scr, lane); }
        }
        for (int m = gw; m < MFULL; m += NGW) {
            const int b = m / LTOK, t = m % LTOK; const float* src = t < NMETA ? meta + (size_t)t * DM : x + ((size_t)b * SEQ + (t - NMETA)) * DM;
            const f32x4* xr = (const f32x4*)src + lane; f32x4 v[4]; float s = 0.f;
#pragma unroll
            for (int j = 0; j < 4; ++j) { v[j] = xr[64 * j]; s += (v[j].x * v[j].x + v[j].y * v[j].y) + (v[j].z * v[j].z + v[j].w * v[j].w); }
            s = wave_sum(s);
            if (lane == 0) RINV[m] = 1.0f / sqrtf(s * (1.0f / DM) + EPS);
            u32x2* o8 = (u32x2*)(HB + (size_t)m * DM) + lane;
#pragma unroll
            for (int j = 0; j < 4; ++j) o8[64 * j] = (u32x2){pk2(v[j].x, v[j].y), pk2(v[j].z, v[j].w)};
        }
        for (int i = bx * (NWAVES * 64) + tid; i < MC; i += G * NWAVES * 64) SSQ[i] = 0.f;
    }
    SEAM(0);

    if (IN(1)) {
        pg8::Gemm g{HB, WIN, MFULL, NIN, DM}; pg8::StaticOrder S; S.init(MFULL, NIN, G, bx);
        pg8::EpiP1 E{RINV, XB, CU, Qb, Kb, Vb, Gb, q_norm_g, k_norm_g, b_gate};
        pg8::gemm_phase<pg8::EpiP1, pg8::StaticOrder, true, true>(lds, g, S, E);
    }
    SEAM(1);

    if (IN(2)) {
        for (int p = vcu; p < NB * 16; p += G)
            for (int j = 7; j >= 0; --j) sb::attn_unit(p >> 4, p & 15, j, Qb, Kb, Vb, Ob, lds);
        for (int item = bx * (NWAVES * 64) + tid; item < (MC / 16) * 128; item += G * NWAVES * 64) {
            const int c0 = (item & 127) * 8, crow0 = (item >> 7) * 16; const int m0 = crow0 + ((crow0 >> 11) + 1) * NMETA;
            f32x4 w0a = *(const f32x4*)(conv_w + c0), w0b = *(const f32x4*)(conv_w + c0 + 4), w1a = *(const f32x4*)(conv_w + DM + c0), w1b = *(const f32x4*)(conv_w + DM + c0 + 4),
                  w2a = *(const f32x4*)(conv_w + 2 * DM + c0), w2b = *(const f32x4*)(conv_w + 2 * DM + c0 + 4);
            f32x4 p2a, p2b, p1a, p1b;
            pg8::unpack8(*(const u32x4*)(CU + (size_t)(m0 - 2) * DM + c0), p2a, p2b); pg8::unpack8(*(const u32x4*)(CU + (size_t)(m0 - 1) * DM + c0), p1a, p1b);
#pragma unroll 4
            for (int i = 0; i < 16; ++i) { f32x4 ca, cb, xa, xbv;
                pg8::unpack8(*(const u32x4*)(CU + (size_t)(m0 + i) * DM + c0), ca, cb); pg8::unpack8(*(const u32x4*)(XB + (size_t)(m0 + i) * DM + c0), xa, xbv);
                const f32x4 ua = xa * (w0a * p2a + w1a * p1a + w2a * ca), ub = xbv * (w0b * p2b + w1b * p1b + w2b * cb);
                *(u32x4*)(Ub + (size_t)(crow0 + i) * DM + c0) = pg8::pack8(ua, ub);
                p2a = p1a; p2b = p1b; p1a = ca; p1b = cb; }
        }
    }
    SEAM(2);

    if (IN(3)) {
        pg8::StaticOrder S; S.init(MC, DM, G, bx);
        { pg8::Gemm g{Ub, WC, MC, DM, DM}; pg8::EpiGate<0> E{Gb, Tb, MMb}; pg8::gemm_phase<pg8::EpiGate<0>, pg8::StaticOrder, true, true>(lds, g, S, E); }
        __threadfence();
        { pg8::Gemm g{Ob, WSB, MC, DM, DM}; pg8::EpiGate<1> E{Gb, Tb, MMb}; pg8::gemm_phase<pg8::EpiGate<1>, pg8::StaticOrder, true, true>(lds, g, S, E); }
    }
    SEAM(3);

    if (IN(4)) {
        pg8::Gemm g{MMb, WO, MC, DM, DM}; pg8::StaticOrder S; S.init(MC, DM, G, bx);
        pg8::EpiH1 E{x, args.out, H1B, SSQ};
        pg8::gemm_phase<pg8::EpiH1, pg8::StaticOrder, true, true>(lds, g, S, E);
    }
    SEAM(4);

    if (IN(5)) {
        pg8::Gemm g{H1B, WFI, MC, NFF2, DM}; pg8::StaticOrder S; S.init(MC, NFF2, G, bx);
        pg8::EpiF1 E{SSQ, ACT};
        pg8::gemm_phase<pg8::EpiF1, pg8::StaticOrder, true, true>(lds, g, S, E);
    }
    SEAM(5);

    if (IN(6)) {
        pg8::Gemm g{ACT, WFO, MC, DM, DFF}; pg8::StaticOrder S; S.init(MC, DM, G, bx);
        pg8::EpiOut E{args.out};
        pg8::gemm_phase<pg8::EpiOut, pg8::StaticOrder, true, true>(lds, g, S, E);
    }
#undef IN
#undef SEAM
}

extern "C" void kernel_launch(void* const* d_in, const int* in_sizes, int n_in, void* d_out, int out_size, void* d_ws, size_t ws_size, hipStream_t stream) {
    static int grid = 0;
    if (grid == 0) {
        if (n_in != 14 || out_size != MC * DM || ws_size < WS_END) { fprintf(stderr, "kernel_launch: unexpected shapes (n_in %d, out %d, ws %zu < %zu)\n", n_in, out_size, ws_size, (size_t)WS_END); grid = -1; return; }
        int dev = 0, cus = 0, per_cu = 0;
        hipGetDevice(&dev); hipDeviceGetAttribute(&cus, hipDeviceAttributeMultiprocessorCount, dev);
        if (hipFuncSetAttribute((const void*)fwd_megakernel, hipFuncAttributeMaxDynamicSharedMemorySize, LDS_BYTES) != hipSuccess) { fprintf(stderr, "kernel_launch: hipFuncSetAttribute failed\n"); grid = -1; return; }
        if (hipOccupancyMaxActiveBlocksPerMultiprocessor(&per_cu, (const void*)fwd_megakernel, NWAVES * 64, LDS_BYTES) != hipSuccess || per_cu < 1) { fprintf(stderr, "kernel_launch: occupancy query says %d\n", per_cu); per_cu = 1; }
        (void)hipGetLastError();
        grid = cus * 1;
    }
    if (grid < 0) return;
    Args a{};
    for (int i = 0; i < 14; ++i) a.in[i] = (const float*)d_in[i];
    a.out = (float*)d_out; a.ws = (unsigned char*)d_ws;
#if MK_N_LAUNCHES == 1
    a.ph_lo = 0; a.ph_hi = N_PHASES;
    void* kargs[] = {&a};
    hipError_t e = hipLaunchCooperativeKernel((const void*)fwd_megakernel, dim3(grid), dim3(NWAVES * 64), kargs, LDS_BYTES, stream);
    if (e != hipSuccess) fprintf(stderr, "kernel_launch: cooperative launch failed: %s (grid %d)\n", hipGetErrorString(e), grid);
#else
    for (int p = 0; p < N_PHASES; ++p) { a.ph_lo = p; a.ph_hi = p + 1; hipLaunchKernelGGL(fwd_megakernel, dim3(grid), dim3(NWAVES * 64), LDS_BYTES, stream, a); }
#endif
}
```

```cpp
#include <hip/hip_runtime.h>
#include <hip/hip_cooperative_groups.h>
#include <cstdio>
#include <cstdint>
namespace cg = cooperative_groups;

#ifndef MK_N_LAUNCHES
#define MK_N_LAUNCHES 1
#endif

#define LAS __attribute__((address_space(3)))
typedef unsigned short bf16_t;
typedef short bf16x8 __attribute__((ext_vector_type(8)));
typedef float f32x4 __attribute__((ext_vector_type(4)));
typedef float f32x16 __attribute__((ext_vector_type(16)));
typedef unsigned u32x4 __attribute__((ext_vector_type(4)));
typedef unsigned u32x2 __attribute__((ext_vector_type(2)));

constexpr int DM = 1024, NB = 32, SEQ = 2048, NMETA = 16, LTOK = SEQ + NMETA;
constexpr int MFULL = NB * LTOK;
constexpr int MC = NB * SEQ;
constexpr int NIN = 8192, DFF = 2816, NFF2 = 2 * DFF;
constexpr float EPS = 1e-6f;
constexpr float LOG2E = 1.4426950408889634f;
constexpr float C2 = 0.125f * LOG2E;

constexpr size_t MiB = 1u << 20;
constexpr size_t WS_BAR = 0;
constexpr size_t WS_SSQ = 512 * 1024;
constexpr size_t WS_WIN = 1 * MiB;
constexpr size_t WS_WC = 17 * MiB, WS_WS = 19 * MiB, WS_WO = 21 * MiB;
constexpr size_t WS_WFI = 23 * MiB;
constexpr size_t WS_WFO = 34 * MiB;
constexpr size_t WS_XB = 40 * MiB, WS_CU = 169 * MiB, WS_Q = 298 * MiB, WS_K = 427 * MiB, WS_V = 556 * MiB;
constexpr size_t WS_G = 685 * MiB;
constexpr size_t WS_END = 943 * MiB;
constexpr size_t WS_T = WS_Q, WS_MM = WS_K, WS_H1B = WS_V;
constexpr size_t WS_ACT = WS_XB;
constexpr size_t OUT_U = 0, OUT_O = 128 * MiB;

namespace pg8 {
constexpr int BM = 256, BK = 64, HALF = 128, HTB = HALF * BK * 2, STAGE_BYTES = 8 * HTB, NXCD = 8, WGM = 8;
__host__ __device__ __forceinline__ int lds_byte(int r, int c) { const int st = (r >> 4) * 2 + (c >> 5), rr = r & 15, cc = c & 31, ob = rr * 64 + cc * 2; return st * 1024 + (ob ^ (((ob >> 9) & 1) << 5)); }
__host__ __device__ __forceinline__ void stage_rc(int b, int& R, int& C) { const int st = b / 1024, sb = b % 1024, swz = sb ^ (((sb >> 9) & 1) << 5); R = (st >> 1) * 16 + swz / 64; C = (st & 1) * 32 + (swz % 64) / 2; }
__host__ __device__ __forceinline__ int perm32(int rho) { const int n = rho >> 4, i = rho & 15; return 8 * (i >> 2) + 4 * n + (i & 3); }

struct Unit { int pm, pn; };
struct Gemm { const bf16_t* A; const bf16_t* Bt; int M, N, K; const bf16_t* A2; const bf16_t* Bt2; int K1; };

struct StaticOrder {
    int nM, nN, nwg, G, c;
    __host__ __device__ void init(int M, int N, int G_, int c_) { nM = M / BM; nN = N / BM; nwg = nM * nN; G = G_; c = c_; }
    __host__ __device__ bool next(int i, Unit& u) const {
        const long L = (long)i * G + c; if (L >= nwg) return false;
        int wgid = (int)L; { const int q = nwg / NXCD, r = nwg % NXCD, xcd = wgid % NXCD, off = wgid / NXCD; wgid = (xcd < r ? xcd * (q + 1) : r * (q + 1) + (xcd - r) * q) + off; }
        const int nig = WGM * nN, gid = wgid / nig, fm = gid * WGM, gsz = (nM - fm) < WGM ? (nM - fm) : WGM;
        u.pm = fm + ((wgid % nig) % gsz); u.pn = (wgid % nig) / gsz; return true;
    }
};

typedef float f32x2_t __attribute__((ext_vector_type(2))); typedef __bf16 bf16x2_t __attribute__((ext_vector_type(2)));
__device__ __forceinline__ unsigned cvt_pk_bf16(float lo, float hi) { const f32x2_t v = {lo, hi}; const bf16x2_t b = __builtin_convertvector(v, bf16x2_t); return __builtin_bit_cast(unsigned, b); }
__device__ __forceinline__ u32x4 pack8(const f32x4 a, const f32x4 b) { u32x4 w; w.x = cvt_pk_bf16(a[0], a[1]); w.y = cvt_pk_bf16(a[2], a[3]); w.z = cvt_pk_bf16(b[0], b[1]); w.w = cvt_pk_bf16(b[2], b[3]); return w; }
__device__ __forceinline__ void unpack8(const u32x4 w, f32x4& a, f32x4& b) {
    a[0] = __uint_as_float(w.x << 16); a[1] = __uint_as_float(w.x & 0xffff0000u); a[2] = __uint_as_float(w.y << 16); a[3] = __uint_as_float(w.y & 0xffff0000u);
    b[0] = __uint_as_float(w.z << 16); b[1] = __uint_as_float(w.z & 0xffff0000u); b[2] = __uint_as_float(w.w << 16); b[3] = __uint_as_float(w.w & 0xffff0000u);
}
__device__ __forceinline__ float sigmoidf_fast(float x) { return __builtin_amdgcn_rcpf(1.0f + __builtin_amdgcn_exp2f(-LOG2E * x)); }

struct EpiP1 {
    static constexpr bool PERM = true, AFTER_DRAIN = false, HAS_MID = false, HAS_PRE = false;
    bf16_t *XB, *CU, *Q, *K, *V, *G; const LAS float* cst;
    __device__ __forceinline__ void operator()(const f32x4 (&acc)[2][2][4][2], const Unit& u, int wr, int wc, int fr, int fq) const {
        const int row0 = u.pm * BM + wr * 64 + fr; const int pn = u.pn;
        if (pn < 4 || (pn >= 20 && pn < 24)) {
            bf16_t* base = (pn < 4 ? XB : V) + (pn & 3) * 256 + wc * 32 + 8 * fq;
#pragma unroll
            for (int ai = 0; ai < 2; ++ai)
#pragma unroll
                for (int m = 0; m < 4; ++m) { const int row = row0 + ai * HALF + m * 16; bf16_t* rowp = base + (size_t)row * DM;
#pragma unroll
                    for (int bj = 0; bj < 2; ++bj) *(u32x4*)(rowp + bj * HALF) = pack8(acc[ai][bj][m][0], acc[ai][bj][m][1]); }
        } else if (pn < 12) {
            bf16_t* base = CU + (pn - 4) * 128 + wc * 32 + 8 * fq;
#pragma unroll
            for (int ai = 0; ai < 2; ++ai)
#pragma unroll
                for (int m = 0; m < 4; ++m) { const int row = row0 + ai * HALF + m * 16;
                    *(u32x4*)(base + (size_t)row * DM) = pack8(acc[ai][0][m][0] * acc[ai][1][m][0], acc[ai][0][m][1] * acc[ai][1][m][1]); }
        } else if (pn < 20) {
            const bool isq = pn < 16; const int head = ((pn - 12) & 3) * 4 + wc; bf16_t* base = (isq ? Q : K) + head * 64 + 8 * fq; const LAS float* gp = cst + (isq ? 0 : 64) + 8 * fq; const float post = isq ? C2 : 1.0f;
            f32x4 gv[2][2];
#pragma unroll
            for (int bj = 0; bj < 2; ++bj)
#pragma unroll
                for (int n = 0; n < 2; ++n) gv[bj][n] = *(const LAS f32x4*)(gp + 32 * bj + 4 * n);
#pragma unroll
            for (int ai = 0; ai < 2; ++ai)
#pragma unroll
                for (int m = 0; m < 4; ++m) { const int row = row0 + ai * HALF + m * 16; float ss = 0.f;
#pragma unroll
                    for (int bj = 0; bj < 2; ++bj)
#pragma unroll
                        for (int n = 0; n < 2; ++n) { const f32x4 x = acc[ai][bj][m][n]; ss += (x[0] * x[0] + x[1] * x[1]) + (x[2] * x[2] + x[3] * x[3]); }
                    ss += __shfl_xor(ss, 16); ss += __shfl_xor(ss, 32);
                    const float rr = __builtin_amdgcn_rsqf(ss * (1.0f / 64.0f) + EPS) * post;
#pragma unroll
                    for (int bj = 0; bj < 2; ++bj) *(u32x4*)(base + (size_t)row * DM + 32 * bj) = pack8(acc[ai][bj][m][0] * rr * gv[bj][0], acc[ai][bj][m][1] * rr * gv[bj][1]); }
        } else {
            const int ch0 = (pn - 24) * 128 + wc * 32 + 8 * fq; bf16_t* base = G + ch0;
            f32x4 bv[2][2];
#pragma unroll
            for (int bj = 0; bj < 2; ++bj)
#pragma unroll
                for (int n = 0; n < 2; ++n) bv[bj][n] = *(const LAS f32x4*)(cst + 128 + bj * 1024 + ch0 + 4 * n);
#pragma unroll
            for (int ai = 0; ai < 2; ++ai)
#pragma unroll
                for (int m = 0; m < 4; ++m) { const int row = row0 + ai * HALF + m * 16; f32x4 rt[2], g1[2];
#pragma unroll
                    for (int n = 0; n < 2; ++n) { const f32x4 x0 = acc[ai][0][m][n] + bv[0][n], x1 = acc[ai][1][m][n] + bv[1][n];
#pragma unroll
                        for (int i = 0; i < 4; ++i) { const float d0 = 1.0f + __builtin_amdgcn_exp2f(-LOG2E * x0[i]), d1 = 1.0f + __builtin_amdgcn_exp2f(-LOG2E * x1[i]);
                            rt[n][i] = d1 * __builtin_amdgcn_rcpf(d0); g1[n][i] = __builtin_amdgcn_rcpf(d1); } }
                    *(u32x4*)(base + (size_t)row * 2048) = pack8(rt[0], rt[1]); *(u32x4*)(base + (size_t)row * 2048 + 1024) = pack8(g1[0], g1[1]); }
        }
    }
};
struct EpiMerged {
    static constexpr bool PERM = true, AFTER_DRAIN = false, HAS_MID = true, HAS_PRE = false;
    const bf16_t* G; bf16_t* MMo;
    __device__ __forceinline__ void mid(f32x4 (&acc)[2][2][4][2], const Unit& u, int wr, int wc, int fr, int fq) const {
        const int row0 = u.pm * BM + wr * 64 + fr; const int goff = ((u.pm >> 3) + 1) * NMETA; const int col0 = u.pn * BM + wc * 32 + 8 * fq;
#pragma unroll
        for (int ai = 0; ai < 2; ++ai)
#pragma unroll
            for (int m = 0; m < 4; ++m) { const bf16_t* gp = G + (size_t)(row0 + ai * HALF + m * 16 + goff) * 2048 + col0;
#pragma unroll
                for (int bj = 0; bj < 2; ++bj) { f32x4 a0, a1; unpack8(__builtin_nontemporal_load((const u32x4*)(gp + bj * HALF)), a0, a1); acc[ai][bj][m][0] *= a0; acc[ai][bj][m][1] *= a1; } }
    }
    __device__ __forceinline__ void operator()(const f32x4 (&acc)[2][2][4][2], const Unit& u, int wr, int wc, int fr, int fq) const {
        const int row0 = u.pm * BM + wr * 64 + fr; const int goff = ((u.pm >> 3) + 1) * NMETA; const int col0 = u.pn * BM + wc * 32 + 8 * fq;
#pragma unroll
        for (int ai = 0; ai < 2; ++ai)
#pragma unroll
            for (int m = 0; m < 4; ++m) { const int row = row0 + ai * HALF + m * 16;
#pragma unroll
                for (int bj = 0; bj < 2; ++bj) { const int col = col0 + bj * HALF;
                    f32x4 b0, b1; unpack8(__builtin_nontemporal_load((const u32x4*)(G + (size_t)(row + goff) * 2048 + 1024 + col)), b0, b1);
                    *(u32x4*)(MMo + (size_t)row * DM + col) = pack8(acc[ai][bj][m][0] * b0, acc[ai][bj][m][1] * b1); } }
    }
};
struct EpiH1 {
    static constexpr bool PERM = true, AFTER_DRAIN = false, HAS_MID = false, HAS_PRE = false;
    const float* x; bf16_t* H1B; float* ssq;
    __device__ __forceinline__ void operator()(const f32x4 (&acc)[2][2][4][2], const Unit& u, int wr, int wc, int fr, int fq) const {
        const int row0 = u.pm * BM + wr * 64 + fr; const int col0 = u.pn * BM + wc * 32 + 8 * fq;
#pragma unroll
        for (int ai = 0; ai < 2; ++ai)
#pragma unroll
            for (int m = 0; m < 4; ++m) { const int row = row0 + ai * HALF + m * 16; float ss = 0.f;
#pragma unroll
                for (int bj = 0; bj < 2; ++bj) { const size_t off = (size_t)row * DM + col0 + bj * HALF;
                    const f32x4 a = __builtin_nontemporal_load((const f32x4*)(x + off)) + acc[ai][bj][m][0], b = __builtin_nontemporal_load((const f32x4*)(x + off + 4)) + acc[ai][bj][m][1];
                    *(u32x4*)(H1B + off) = pack8(a, b);
                    ss += (a[0] * a[0] + a[1] * a[1]) + (a[2] * a[2] + a[3] * a[3]) + (b[0] * b[0] + b[1] * b[1]) + (b[2] * b[2] + b[3] * b[3]); }
                ss += __shfl_xor(ss, 16); ss += __shfl_xor(ss, 32);
                if (fq == 0) atomicAdd(ssq + row, ss); }
    }
};
struct EpiF1 {
    static constexpr bool PERM = true, AFTER_DRAIN = false, HAS_MID = false, HAS_PRE = true;
    const float* ssq; bf16_t* ACT; LAS float* slot;
    __device__ __forceinline__ void pre(const Unit& u, int ui, int wid, int lane) const {
        if (wid < 4) __builtin_amdgcn_global_load_lds((const unsigned*)(ssq + u.pm * BM + wid * 64 + lane), (LAS unsigned*)(slot + (ui & 1) * BM + wid * 64), 4, 0, 0);
    }
    __device__ __forceinline__ void operator()(const f32x4 (&acc)[2][2][4][2], const Unit& u, int wr, int wc, int fr, int fq, int ui) const {
        const int col0 = u.pn * 128 + wc * 32 + 8 * fq; const LAS float* sq = slot + (ui & 1) * BM;
#pragma unroll
        for (int ai = 0; ai < 2; ++ai)
#pragma unroll
            for (int m = 0; m < 4; ++m) { const int rl = wr * 64 + fr + ai * HALF + m * 16; const int row = u.pm * BM + rl; const float ri = __builtin_amdgcn_rsqf(sq[rl] * (1.0f / DM) + EPS);
                f32x4 o[2];
#pragma unroll
                for (int n = 0; n < 2; ++n) { const f32x4 g = acc[ai][0][m][n] * ri, up = acc[ai][1][m][n] * ri;
#pragma unroll
                    for (int i = 0; i < 4; ++i) o[n][i] = g[i] * sigmoidf_fast(g[i]) * up[i]; }
                *(u32x4*)(ACT + (size_t)row * DFF + col0) = pack8(o[0], o[1]); }
    }
};
struct EpiOut {
    static constexpr bool PERM = true, AFTER_DRAIN = false, HAS_MID = false, HAS_PRE = false;
    const bf16_t* H1B; float* out;
    __device__ __forceinline__ void operator()(const f32x4 (&acc)[2][2][4][2], const Unit& u, int wr, int wc, int fr, int fq) const {
        const int row0 = u.pm * BM + wr * 64 + fr; const int col0 = u.pn * BM + wc * 32 + 8 * fq;
#pragma unroll
        for (int ai = 0; ai < 2; ++ai)
#pragma unroll
            for (int m = 0; m < 4; ++m) { const int row = row0 + ai * HALF + m * 16;
#pragma unroll
                for (int bj = 0; bj < 2; ++bj) { const size_t off = (size_t)row * DM + col0 + bj * HALF;
                    f32x4 h0, h1; unpack8(__builtin_nontemporal_load((const u32x4*)(H1B + off)), h0, h1);
                    __builtin_nontemporal_store(h0 + acc[ai][bj][m][0], (f32x4*)(out + off)); __builtin_nontemporal_store(h1 + acc[ai][bj][m][1], (f32x4*)(out + off + 4)); } }
    }
};

template <class Epi, class Sched, bool ALIGN_EPI = false, bool SP2 = false>
__device__ __forceinline__ void gemm_phase(LAS unsigned char* lds, const Gemm g, const Sched& S, const Epi& E) {
    const int tid = threadIdx.x, wid = __builtin_amdgcn_readfirstlane(tid >> 6), lane = tid & 63, wr = wid >> 2, wc = wid & 3, fr = lane & 15, fq = lane >> 4;
    const int K = g.K, nt = K / BK, ld = g.K1, nt1 = g.K1 / BK;
    unsigned voffA[2], voffB[2];
#pragma unroll
    for (int i = 0; i < 2; ++i) { int R, C; stage_rc(tid * 16 + i * 8192, R, C); const int Rb = Epi::PERM ? ((R & ~31) + perm32(R & 31)) : R;
        voffA[i] = (unsigned)(R * ld + C) * 2u; voffB[i] = (unsigned)(Rb * ld + C) * 2u; }
    const size_t kstep = (size_t)(BK * 2);
    const size_t hstep = (size_t)HALF * ld * 2;
    const size_t tstep = 2 * hstep;
    const unsigned ldsw = (unsigned)wid * 1024u;
    const int aoff = lds_byte(wr * 64 + fr, fq * 8), boff = lds_byte(wc * 32 + fr, fq * 8);
#define PG8_SA(b, h) (((b) * 2 + (h)) * HTB)
#define PG8_SB(b, h) ((4 + (b) * 2 + (h)) * HTB)
#define PG8_STAGE(bufoff, gbase, voff) do { _Pragma("unroll") for (int _i = 0; _i < 2; ++_i) \
        __builtin_amdgcn_global_load_lds((const unsigned*)((const char*)(gbase) + (voff)[_i]), (LAS unsigned*)(lds + (bufoff) + ldsw + _i * 8192), 16, 0, 0); } while (0)
#define PG8_LDA(dst, b, h) do { _Pragma("unroll") for (int m = 0; m < 4; ++m) _Pragma("unroll") for (int k = 0; k < 2; ++k) dst[m][k] = *(const LAS bf16x8*)(lds + PG8_SA(b, h) + aoff + m * 2048 + k * 1024); } while (0)
#define PG8_LDB(dst, b, h) do { _Pragma("unroll") for (int n = 0; n < 2; ++n) _Pragma("unroll") for (int k = 0; k < 2; ++k) dst[n][k] = *(const LAS bf16x8*)(lds + PG8_SB(b, h) + boff + n * 2048 + k * 1024); } while (0)
#define PG8_MMA(ai, bj, At, Bt) do { __builtin_amdgcn_s_setprio(1); _Pragma("unroll") for (int m = 0; m < 4; ++m) _Pragma("unroll") for (int n = 0; n < 2; ++n) _Pragma("unroll") for (int k = 0; k < 2; ++k) \
        acc[ai][bj][m][n] = __builtin_amdgcn_mfma_f32_16x16x32_bf16(Bt[n][k], At[m][k], acc[ai][bj][m][n], 0, 0, 0); __builtin_amdgcn_s_setprio(0); } while (0)
#define PG8_WAIT_V(n) asm volatile("s_waitcnt vmcnt(" #n ")" ::: "memory")
#define PG8_WAIT_L(n) asm volatile("s_waitcnt lgkmcnt(" #n ")" ::: "memory")
#define PG8_BAR __builtin_amdgcn_s_barrier()
#define PG8_SCHED __builtin_amdgcn_sched_barrier(0)
    Unit cur, nxt; int ui = 0;
    if (!S.next(0, cur)) return;
    f32x4 acc[2][2][4][2];
#pragma unroll
    for (int a = 0; a < 2; ++a)
#pragma unroll
        for (int b = 0; b < 2; ++b)
#pragma unroll
            for (int m = 0; m < 4; ++m)
#pragma unroll
                for (int n = 0; n < 2; ++n) acc[a][b][m][n] = (f32x4){0.f, 0.f, 0.f, 0.f};
    bf16x8 At[4][2], B0[2][2], B1[2][2];
    const char* cA = (const char*)g.A + (size_t)cur.pm * tstep; const char* cB = (const char*)g.Bt + (size_t)cur.pn * tstep;
    if constexpr (Epi::HAS_PRE) E.pre(cur, 0, wid, lane);
    if constexpr (SP2) {
        PG8_STAGE(PG8_SB(0, 0), cB, voffB); PG8_STAGE(PG8_SB(0, 1), cB + hstep, voffB); PG8_STAGE(PG8_SA(0, 0), cA, voffA); PG8_STAGE(PG8_SA(0, 1), cA + hstep, voffA);
        if (wr == 1) PG8_BAR;
        PG8_WAIT_V(2); PG8_BAR;
        PG8_STAGE(PG8_SB(1, 0), cB + kstep, voffB); PG8_STAGE(PG8_SA(1, 0), cA + kstep, voffA); PG8_STAGE(PG8_SB(1, 1), cB + hstep + kstep, voffB);
        PG8_WAIT_V(6); PG8_BAR;
    } else {
        PG8_STAGE(PG8_SB(0, 0), cB, voffB); PG8_STAGE(PG8_SA(0, 0), cA, voffA); PG8_STAGE(PG8_SB(0, 1), cB + hstep, voffB); PG8_STAGE(PG8_SA(0, 1), cA + hstep, voffA);
        if (wr == 1) PG8_BAR;
        PG8_WAIT_V(4); PG8_BAR;
        PG8_STAGE(PG8_SB(1, 0), cB + kstep, voffB); PG8_STAGE(PG8_SA(1, 0), cA + kstep, voffA); PG8_STAGE(PG8_SB(1, 1), cB + hstep + kstep, voffB);
        PG8_WAIT_V(6); PG8_BAR;
    }
    for (;;) {
        const bool has_next = S.next(ui + 1, nxt);
        const char* nA = has_next ? (const char*)g.A + (size_t)nxt.pm * tstep : cA; const char* nB = has_next ? (const char*)g.Bt + (size_t)nxt.pn * tstep : cB;
        for (int t = 0; t < nt; t += 2) {
            const bool last = (t == nt - 2);
            const char* a1 = t < nt1 ? cA + (size_t)(t + 1) * kstep : (const char*)g.A2 + (size_t)cur.pm * tstep + (size_t)(t + 1 - nt1) * kstep;
            const char* a2 = last ? nA : (t + 2 < nt1 ? cA + (size_t)(t + 2) * kstep : (const char*)g.A2 + (size_t)cur.pm * tstep + (size_t)(t + 2 - nt1) * kstep);
            const char* b2 = last ? nB : (t + 2 < nt1 ? cB + (size_t)(t + 2) * kstep : (const char*)g.Bt2 + (size_t)cur.pn * tstep + (size_t)(t + 2 - nt1) * kstep);
            const char* a3 = a2 + kstep; const char* b3 = b2 + kstep;
            if constexpr (SP2) {
            PG8_LDB(B0, 0, 0); PG8_LDB(B1, 0, 1); PG8_SCHED; PG8_LDA(At, 0, 0); PG8_STAGE(PG8_SA(1, 1), a1 + hstep, voffA);
            PG8_WAIT_V(8); PG8_WAIT_L(0); PG8_BAR; PG8_MMA(0, 0, At, B0); PG8_MMA(0, 1, At, B1); PG8_BAR; PG8_SCHED;
            PG8_LDA(At, 0, 1); PG8_STAGE(PG8_SB(0, 0), b2, voffB); PG8_STAGE(PG8_SB(0, 1), b2 + hstep, voffB); PG8_STAGE(PG8_SA(0, 0), a2, voffA);
            PG8_WAIT_V(8); PG8_WAIT_L(0); PG8_BAR; PG8_MMA(1, 0, At, B0); PG8_MMA(1, 1, At, B1); PG8_BAR; PG8_SCHED;
            PG8_LDB(B0, 1, 0); PG8_LDB(B1, 1, 1); PG8_SCHED; PG8_LDA(At, 1, 0); PG8_STAGE(PG8_SA(0, 1), a2 + hstep, voffA);
            PG8_WAIT_V(8); PG8_WAIT_L(0); PG8_BAR; PG8_MMA(0, 0, At, B0); PG8_MMA(0, 1, At, B1); PG8_BAR; PG8_SCHED;
            PG8_LDA(At, 1, 1); PG8_STAGE(PG8_SB(1, 0), b3, voffB); PG8_STAGE(PG8_SB(1, 1), b3 + hstep, voffB); PG8_STAGE(PG8_SA(1, 0), a3, voffA);
            PG8_WAIT_V(8); PG8_WAIT_L(0); PG8_BAR; PG8_MMA(1, 0, At, B0); PG8_MMA(1, 1, At, B1); PG8_BAR; PG8_SCHED;
            } else {
            PG8_LDB(B0, 0, 0); PG8_SCHED; PG8_LDA(At, 0, 0); PG8_STAGE(PG8_SA(1, 1), a1 + hstep, voffA);
            PG8_WAIT_L(8); PG8_BAR; PG8_WAIT_L(0); PG8_MMA(0, 0, At, B0); PG8_BAR; PG8_SCHED;
            PG8_LDB(B1, 0, 1); PG8_STAGE(PG8_SB(0, 0), b2, voffB);
            PG8_BAR; PG8_WAIT_L(0); PG8_MMA(0, 1, At, B1); PG8_BAR;
            PG8_LDA(At, 0, 1); PG8_STAGE(PG8_SA(0, 0), a2, voffA);
            PG8_BAR; PG8_WAIT_L(0); PG8_MMA(1, 0, At, B0); PG8_BAR; PG8_SCHED;
            PG8_STAGE(PG8_SB(0, 1), b2 + hstep, voffB);
            PG8_WAIT_V(6); PG8_BAR; PG8_MMA(1, 1, At, B1); PG8_BAR;
            PG8_LDB(B0, 1, 0); PG8_SCHED; PG8_LDA(At, 1, 0); PG8_STAGE(PG8_SA(0, 1), a2 + hstep, voffA);
            PG8_WAIT_L(8); PG8_BAR; PG8_WAIT_L(0); PG8_MMA(0, 0, At, B0); PG8_BAR; PG8_SCHED;
            PG8_LDB(B1, 1, 1); PG8_STAGE(PG8_SB(1, 0), b3, voffB);
            PG8_BAR; PG8_WAIT_L(0); PG8_MMA(0, 1, At, B1); PG8_BAR;
            PG8_LDA(At, 1, 1); PG8_STAGE(PG8_SA(1, 0), a3, voffA);
            PG8_BAR; PG8_WAIT_L(0); PG8_MMA(1, 0, At, B0); PG8_BAR; PG8_SCHED;
            PG8_STAGE(PG8_SB(1, 1), b3 + hstep, voffB);
            PG8_WAIT_V(6); PG8_BAR; PG8_MMA(1, 1, At, B1); PG8_BAR;
            }
            if constexpr (Epi::HAS_MID) { if (t + 2 == nt1) E.mid(acc, cur, wr, wc, fr, fq); }
        }
        if constexpr (ALIGN_EPI) { if (wr == 0) PG8_BAR; }
        if constexpr (Epi::HAS_PRE) { E(acc, cur, wr, wc, fr, fq, ui); if (has_next) E.pre(nxt, ui + 1, wid, lane); }
        else E(acc, cur, wr, wc, fr, fq);
        if (!has_next) break;
#pragma unroll
        for (int a = 0; a < 2; ++a)
#pragma unroll
            for (int b = 0; b < 2; ++b)
#pragma unroll
                for (int m = 0; m < 4; ++m)
#pragma unroll
                    for (int n = 0; n < 2; ++n) acc[a][b][m][n] = (f32x4){0.f, 0.f, 0.f, 0.f};
        cur = nxt; cA = nA; cB = nB; ++ui;
        if constexpr (ALIGN_EPI) { if (wr == 1) PG8_BAR; }
    }
    PG8_WAIT_V(0);
    if constexpr (!ALIGN_EPI) { if (wr == 0) PG8_BAR; }
    PG8_BAR;
#undef PG8_SA
#undef PG8_SB
#undef PG8_STAGE
#undef PG8_LDA
#undef PG8_LDB
#undef PG8_MMA
#undef PG8_WAIT_V
#undef PG8_WAIT_L
#undef PG8_BAR
#undef PG8_SCHED
}
}

namespace sb {
constexpr int KBUF = 8192, LDS_V0 = 2 * KBUF;
__device__ __forceinline__ unsigned cvtpk(float lo, float hi) { return pg8::cvt_pk_bf16(lo, hi); }
typedef short v4i16_t __attribute__((ext_vector_type(4)));
__device__ __forceinline__ v4i16_t vtr(const LAS unsigned char* p) { return __builtin_amdgcn_ds_read_tr16_b64_v4i16((LAS v4i16_t*)p); }

__device__ __forceinline__ void qk_tile(f32x16& p0, f32x16& p1, const LAS unsigned char* Kb, const bf16x8 (&qr)[4]) {
    bf16x8 kf[8];
#pragma unroll
    for (int d0 = 0; d0 < 4; ++d0) { kf[2 * d0] = *(const LAS bf16x8*)(Kb + d0 * 2048); kf[2 * d0 + 1] = *(const LAS bf16x8*)(Kb + d0 * 2048 + 512); }
    __builtin_amdgcn_sched_barrier(0);
    p0 = (f32x16){}; p1 = (f32x16){};
#pragma unroll
    for (int d0 = 0; d0 < 4; ++d0) p0 = __builtin_amdgcn_mfma_f32_32x32x16_bf16(kf[2 * d0], qr[d0], p0, 0, 0, 0);
#pragma unroll
    for (int d0 = 0; d0 < 4; ++d0) p1 = __builtin_amdgcn_mfma_f32_32x32x16_bf16(kf[2 * d0 + 1], qr[d0], p1, 0, 0, 0);
}
__device__ __forceinline__ void v_frags(bf16x8 (&vf)[8], const LAS unsigned char* Vb) {
#pragma unroll
    for (int ks = 0; ks < 4; ++ks) { const int ko = ((ks >> 1) * 4 + (ks & 1)) * 512;
        { const v4i16_t lo = vtr(Vb + ko), hh = vtr(Vb + ko + 256); vf[ks] = (bf16x8){lo[0], lo[1], lo[2], lo[3], hh[0], hh[1], hh[2], hh[3]}; }
        { const v4i16_t lo = vtr(Vb + 4096 + ko), hh = vtr(Vb + 4096 + ko + 256); vf[4 + ks] = (bf16x8){lo[0], lo[1], lo[2], lo[3], hh[0], hh[1], hh[2], hh[3]}; } }
}
typedef float f32x2 __attribute__((ext_vector_type(2)));
__device__ __forceinline__ void sb_weights(f32x16& p0, f32x16& p1, float& carry, u32x4 (&pw)[4], bool diag, int t, int kb, int hi) {
    if (diag) {
#pragma unroll
        for (int r = 0; r < 16; ++r) { if (kb + r >= t) p0[r] = -INFINITY; if (kb + 32 + r >= t) p1[r] = -INFINITY; }
    }
    f32x2 u[16], tg[4];
#pragma unroll
    for (int g = 0; g < 4; ++g) {
        f32x2 e0, e1, e2, e3;
        e0.x = __builtin_amdgcn_exp2f(p0[4 * g]);     e0.y = __builtin_amdgcn_exp2f(p1[4 * g]);
        e1.x = __builtin_amdgcn_exp2f(p0[4 * g + 1]); e1.y = __builtin_amdgcn_exp2f(p1[4 * g + 1]);
        e2.x = __builtin_amdgcn_exp2f(p0[4 * g + 2]); e2.y = __builtin_amdgcn_exp2f(p1[4 * g + 2]);
        e3.x = __builtin_amdgcn_exp2f(p0[4 * g + 3]); e3.y = __builtin_amdgcn_exp2f(p1[4 * g + 3]);
        const f32x2 d0 = e0 + 1.0f, d1 = e1 + 1.0f, d2 = e2 + 1.0f, d3 = e3 + 1.0f;
        const f32x2 q1 = d0 * d1, q2 = q1 * d2, dd = q2 * d3;
        tg[g].x = __builtin_amdgcn_rcpf(dd.x); tg[g].y = __builtin_amdgcn_rcpf(dd.y);
        u[4 * g] = e0; u[4 * g + 1] = d0 * e1; u[4 * g + 2] = q1 * e2; u[4 * g + 3] = q2 * e3;
    }
    const f32x2 TT = (tg[0] * tg[1]) * (tg[2] * tg[3]);
    const float T0 = TT.x, T1 = TT.y;
    const auto s0 = __builtin_amdgcn_permlane32_swap(__float_as_uint(T0), __float_as_uint(T0), false, false);
    const auto s1 = __builtin_amdgcn_permlane32_swap(__float_as_uint(T1), __float_as_uint(T1), false, false);
    const float T0lo = __uint_as_float(s0[0]), T0hi = __uint_as_float(s0[1]), T1lo = __uint_as_float(s1[0]), T1hi = __uint_as_float(s1[1]);
    const float cW1 = carry * (T1lo * T1hi);
    const float E1 = hi ? carry : carry * T1hi;
    const float E0 = hi ? cW1 : cW1 * T0hi;
    carry = cW1 * (T0lo * T0hi);
    f32x2 y = {E0, E1};
#pragma unroll
    for (int g = 3; g >= 0; --g) { y *= tg[g];
#pragma unroll
        for (int k = 0; k < 4; ++k) u[4 * g + k] *= y; }
    pw[0] = (u32x4){cvtpk(u[0].x, u[1].x), cvtpk(u[2].x, u[3].x), cvtpk(u[4].x, u[5].x), cvtpk(u[6].x, u[7].x)};
    pw[1] = (u32x4){cvtpk(u[8].x, u[9].x), cvtpk(u[10].x, u[11].x), cvtpk(u[12].x, u[13].x), cvtpk(u[14].x, u[15].x)};
    pw[2] = (u32x4){cvtpk(u[0].y, u[1].y), cvtpk(u[2].y, u[3].y), cvtpk(u[4].y, u[5].y), cvtpk(u[6].y, u[7].y)};
    pw[3] = (u32x4){cvtpk(u[8].y, u[9].y), cvtpk(u[10].y, u[11].y), cvtpk(u[12].y, u[13].y), cvtpk(u[14].y, u[15].y)};
}

__device__ __forceinline__ void attn_unit(int b, int h, int j, const bf16_t* __restrict__ Q, const bf16_t* __restrict__ K, const bf16_t* __restrict__ V, bf16_t* __restrict__ O, LAS unsigned char* lds) {
    const int tid = threadIdx.x, lane = tid & 63, r32 = lane & 31, hi = lane >> 5; const int wid = __builtin_amdgcn_readfirstlane(tid >> 6);
    const long rowbase = (long)b * LTOK;
    const int t0 = NMETA + 256 * j + 32 * wid;
    const int c_top = 4 * j + 4, c_hi = (t0 + 30) >> 6;
    bf16x8 qr[4];
    { const bf16_t* Qw = Q + (rowbase + t0 + r32) * DM + h * 64 + hi * 8;
#pragma unroll
      for (int d0 = 0; d0 < 4; ++d0) qr[d0] = *(const bf16x8*)(Qw + d0 * 16); }
    const int skey = 8 * wid + (lane >> 3), sch = lane & 7;
    const bf16_t* kcol = K + h * 64 + sch * 8; const bf16_t* vcol = V + h * 64 + sch * 8;
    const unsigned ksoff = (unsigned)sch * 1024u + (unsigned)skey * 16u;
    const unsigned vsoff = (unsigned)(sch >> 2) * 4096u + (unsigned)wid * 512u + (unsigned)(lane >> 3) * 64u + (unsigned)(sch & 3) * 16u;
    u32x4 kE, vE, kO, vO;
#define SB_LOAD(c, KR, VR) do { int kk = (c) * 64 + skey; kk = kk < LTOK ? kk : LTOK - 1; \
        KR = *(const u32x4*)(kcol + (rowbase + kk) * DM); VR = *(const u32x4*)(vcol + (rowbase + kk) * DM); } while (0)
#define SB_STORE(buf, KR, VR) do { *(LAS u32x4*)(lds + (buf) * KBUF + ksoff) = KR; *(LAS u32x4*)(lds + LDS_V0 + (buf) * KBUF + vsoff) = VR; } while (0)
    SB_LOAD(c_top, kE, vE); SB_LOAD(c_top - 1, kO, vO); SB_STORE(0, kE, vE);
    __syncthreads();
    f32x16 o0 = {}, o1 = {}; float carry = 1.0f;
    const int kperm = 16 * ((r32 >> 2) & 1) + (r32 & 3) + 4 * (r32 >> 3);
    const unsigned kfo = (unsigned)hi * 1024u + (unsigned)kperm * 16u;
    const unsigned vfo = (unsigned)LDS_V0 + (unsigned)(2 * hi) * 512u + (unsigned)((lane & 15) >> 2) * 64u + (unsigned)((lane >> 4) & 1) * 32u + (unsigned)(lane & 3) * 8u;
    const int tq = t0 + r32;
#define SB_COMPUTE(c, buf) do { if ((c) <= c_hi) { f32x16 p0, p1; bf16x8 vf[8]; u32x4 pw[4]; \
            qk_tile(p0, p1, lds + (buf) * KBUF + kfo, qr); v_frags(vf, lds + (buf) * KBUF + vfo); __builtin_amdgcn_sched_barrier(0); \
            sb_weights(p0, p1, carry, pw, (c) * 64 + 63 >= t0, tq, (c) * 64 + 16 * hi, hi); \
            _Pragma("unroll") for (int kk = 0; kk < 4; ++kk) { const int ks = (kk + 2) & 3;     \
                o0 = __builtin_amdgcn_mfma_f32_32x32x16_bf16(__builtin_bit_cast(bf16x8, pw[ks]), vf[ks], o0, 0, 0, 0); \
                o1 = __builtin_amdgcn_mfma_f32_32x32x16_bf16(__builtin_bit_cast(bf16x8, pw[ks]), vf[4 + ks], o1, 0, 0, 0); } } } while (0)
    for (int c = c_top; c >= 0; c -= 2) {
        if (c >= 2) SB_LOAD(c - 2, kE, vE);
        SB_COMPUTE(c, 0);
        if (c >= 1) SB_STORE(1, kO, vO);
        __syncthreads();
        if (c >= 1) {
            if (c >= 3) SB_LOAD(c - 3, kO, vO);
            SB_COMPUTE(c - 1, 1);
            if (c >= 2) SB_STORE(0, kE, vE);
            __syncthreads();
        }
    }
#undef SB_LOAD
#undef SB_STORE
#undef SB_COMPUTE
    bf16_t* Ow = O + ((size_t)b * SEQ + (t0 - NMETA)) * DM + h * 64 + r32;
#pragma unroll
    for (int r = 0; r < 16; ++r) { const int q = (r & 3) + 8 * (r >> 2) + 4 * hi;
        Ow[(size_t)q * DM] = (bf16_t)(cvtpk(o0[r], 0.f) & 0xffffu); Ow[(size_t)q * DM + 32] = (bf16_t)(cvtpk(o1[r], 0.f) & 0xffffu); }
}
}

__device__ __forceinline__ unsigned f2bf(float f) { unsigned u = __builtin_bit_cast(unsigned, f); return (u + 0x7fffu + ((u >> 16) & 1u)) >> 16; }
__device__ __forceinline__ unsigned pk2(float lo, float hi) { return f2bf(lo) | (f2bf(hi) << 16); }
__device__ __forceinline__ float wave_sum(float v) {
#pragma unroll
    for (int o = 1; o < 64; o <<= 1) v += __shfl_xor(v, o);
    return v;
}
__device__ __forceinline__ int map_win(int s) {
    if (s < 1024) return s;
    if (s < 2048) { const int c = s - 1024; return 1024 + (c >> 7) * 256 + (c & 127); }
    if (s < 3072) { const int c = s - 2048; return 1024 + (c >> 7) * 256 + 128 + (c & 127); }
    if (s < 5120) { const int base = s < 4096 ? 3072 : 4096, c = s - base, hh = c >> 6, d = c & 63; return base + (hh >> 2) * 256 + (d >> 5) * 128 + (hh & 3) * 32 + (d & 31); }
    if (s >= 6144) { const int c = s - 6144, br = c >> 10, ch = c & 1023; return 6144 + (ch >> 7) * 256 + br * 128 + (ch & 127); }
    return s;
}
__device__ __forceinline__ int map_wfi(int s) { const int up = s >= DFF, j = up ? s - DFF : s; return (j >> 7) * 256 + up * 128 + (j & 127); }
__device__ __forceinline__ void p0_transpose_item(const float* W, int K, int N, bf16_t* WT, int k0, int n0, int drow0, const float* gain, LAS float* scr, int lane) {
    float tv[32];
#pragma unroll
    for (int i = 0; i < 32; ++i) tv[i] = __builtin_nontemporal_load(W + (size_t)(k0 + 2 * i + (lane >> 5)) * N + n0 + (lane & 31));
    if (gain) {
#pragma unroll
        for (int i = 0; i < 32; ++i) tv[i] *= gain[k0 + 2 * i + (lane >> 5)]; }
#pragma unroll
    for (int i = 0; i < 32; ++i) scr[(2 * i + (lane >> 5)) * 33 + (lane & 31)] = tv[i];
    asm volatile("s_waitcnt lgkmcnt(0)" ::: "memory");
    const int c = lane & 7;
#pragma unroll
    for (int j = 0; j < 4; ++j) { const int n = (lane >> 3) + 8 * j; const LAS float* s = scr + (8 * c) * 33 + n;
        u32x4 o; o.x = pk2(s[0 * 33], s[1 * 33]); o.y = pk2(s[2 * 33], s[3 * 33]); o.z = pk2(s[4 * 33], s[5 * 33]); o.w = pk2(s[6 * 33], s[7 * 33]);
        *(u32x4*)(WT + (size_t)(drow0 + n) * K + k0 + 8 * c) = o; }
    asm volatile("s_waitcnt lgkmcnt(0)" ::: "memory");
}

#define XB_TMO      128
#define XB_XCNT(j)  (256  + 64 * (j))
#define XB_XSUB(j)  (1280 + 64 * (j))
#define XB_XGEN(j)  (2304 + 64 * (j))
#define XB_TOP      3328
#define XB_TOPGEN   3392
#define XCD_BAR_WORDS 3456
#define XB_SPIN_CAP (1u << 20)
__device__ __forceinline__ unsigned xb_ld(unsigned* p)              { return __hip_atomic_load(p, __ATOMIC_RELAXED, __HIP_MEMORY_SCOPE_AGENT); }
__device__ __forceinline__ unsigned xb_add(unsigned* p, unsigned v) { return __hip_atomic_fetch_add(p, v, __ATOMIC_RELAXED, __HIP_MEMORY_SCOPE_AGENT); }
__device__ __forceinline__ unsigned xb_xcc_id() { return (unsigned)__builtin_amdgcn_s_getreg((3 << 11) | 20) & 0xFu; }
#define XB_SPIN(cond, bar) do { unsigned _sp = 0; while (cond) { __builtin_amdgcn_s_sleep(1); \
    if ((++_sp & 255u) == 0u) { if (xb_ld(&(bar)[XB_TMO])) break; if (_sp > XB_SPIN_CAP) { atomicAdd(&(bar)[XB_TMO], 1u); break; } } } } while (0)
struct XcdBarrier { unsigned* bar; unsigned x; volatile LAS unsigned* st; };
__device__ __forceinline__ XcdBarrier xcd_barrier_post(unsigned* bar, volatile LAS unsigned* st) {
    XcdBarrier b; b.bar = bar; b.x = xb_xcc_id(); b.st = st;
    if (threadIdx.x == 0) (void)xb_add(&bar[XB_XCNT(b.x)], 1u);
    return b;
}
__device__ __forceinline__ void xcd_barrier_complete(unsigned* bar, unsigned x, unsigned& nloc, unsigned& nx) {
    const unsigned G = gridDim.x * gridDim.y * gridDim.z;
    unsigned sum, cnt, mine, sp = 0u;
    for (;;) {
        sum = 0u; cnt = 0u; mine = 0u;
#pragma unroll
        for (unsigned j = 0; j < 16; ++j) { const unsigned c = xb_ld(&bar[XB_XCNT(j)]); sum += c; cnt += (c > 0u) ? 1u : 0u; mine = (j == x) ? c : mine; }
        if (sum == G) break;
        __builtin_amdgcn_s_sleep(1);
        if ((++sp & 255u) == 0u) { if (xb_ld(&bar[XB_TMO])) break; if (sp > XB_SPIN_CAP) { atomicAdd(&bar[XB_TMO], 1u); break; } }
    }
    nloc = mine > 0u ? mine : 1u; nx = cnt > 0u ? cnt : 1u;
}
__device__ __forceinline__ void xcd_barrier(const XcdBarrier& b) {
    asm volatile("s_waitcnt vmcnt(0)" ::: "memory");
    __syncthreads();
    if (threadIdx.x == 0) {
        unsigned* bar = b.bar;
        __builtin_amdgcn_s_waitcnt(0);
        unsigned nloc = b.st[0], nx = b.st[1];
        if (nloc == 0u) { xcd_barrier_complete(bar, b.x, nloc, nx); b.st[0] = nloc; b.st[1] = nx; }
        const unsigned old = xb_add(&bar[XB_XSUB(b.x)], 1u);
        const unsigned gen = old / nloc;
        if (old + 1u == (gen + 1u) * nloc) {
            __builtin_amdgcn_fence(__ATOMIC_RELEASE, "agent");
            asm volatile("s_waitcnt vmcnt(0)" ::: "memory");
            const unsigned og = xb_add(&bar[XB_TOP], 1u);
            const unsigned tg = og / nx;
            if (og + 1u == (tg + 1u) * nx) xb_add(&bar[XB_TOPGEN], 1u);
            else XB_SPIN(xb_ld(&bar[XB_TOPGEN]) == tg, bar);
            __builtin_amdgcn_fence(__ATOMIC_ACQUIRE, "agent");
            xb_add(&bar[XB_XGEN(b.x)], 1u);
            asm volatile("s_waitcnt vmcnt(0)" ::: "memory");
        } else {
            XB_SPIN(xb_ld(&bar[XB_XGEN(b.x)]) == gen, bar);
            __builtin_amdgcn_fence(__ATOMIC_ACQUIRE, "agent");
            asm volatile("s_waitcnt vmcnt(0)" ::: "memory");
        }
    }
    __syncthreads();
}

__device__ __forceinline__ void stagger(int ticks) {
    const int pos = (blockIdx.x >> 3) & 31; const unsigned long long dt = (unsigned long long)((pos * ticks) >> 5);
    const unsigned long long t0 = __builtin_amdgcn_s_memrealtime();
    while (__builtin_amdgcn_s_memrealtime() - t0 < dt) __builtin_amdgcn_s_sleep(8);
}
struct Args { const float* in[14]; float* out; unsigned char* ws; int ph_lo, ph_hi; };
constexpr int NWAVES = 8, LDS_BYTES = 147456, N_PHASES = 7;
constexpr int STAG_P1 = 0, STAG_P3 = 0, STAG_P4 = 0, STAG_P5 = 0, STAG_P6 = 0;

__global__ void __launch_bounds__(NWAVES * 64, 2) fwd_megakernel(Args args) {
    extern __shared__ __attribute__((aligned(16))) unsigned char lds_raw[];
    LAS unsigned char* lds = (LAS unsigned char*)lds_raw;
    cg::grid_group grid = cg::this_grid();
    const int tid = threadIdx.x, lane = tid & 63, wave = __builtin_amdgcn_readfirstlane(tid >> 6);
    const int G = gridDim.x, bx = blockIdx.x;
    const int vcu = (G % 8 == 0) ? (bx % 8) * (G / 8) + bx / 8 : bx;
    unsigned char* ws = args.ws; unsigned char* ob = (unsigned char*)args.out;
    const float* x = args.in[0]; const float* meta = args.in[1]; const float* norm1_g = args.in[2]; const float* w_in = args.in[3]; const float* b_gate = args.in[4];
    const float* conv_w = args.in[5]; const float* w_conv_out = args.in[6]; const float* q_norm_g = args.in[7]; const float* k_norm_g = args.in[8]; const float* w_sb_out = args.in[9];
    const float* w_o = args.in[10]; const float* norm2_g = args.in[11]; const float* w_ffn_in = args.in[12]; const float* w_ffn_out = args.in[13];
    float* SSQ = (float*)(ws + WS_SSQ);
    bf16_t* WIN = (bf16_t*)(ws + WS_WIN); bf16_t* WC = (bf16_t*)(ws + WS_WC); bf16_t* WSB = (bf16_t*)(ws + WS_WS); bf16_t* WO = (bf16_t*)(ws + WS_WO);
    bf16_t* WFI = (bf16_t*)(ws + WS_WFI); bf16_t* WFO = (bf16_t*)(ws + WS_WFO);
    bf16_t* XB = (bf16_t*)(ws + WS_XB); bf16_t* CU = (bf16_t*)(ws + WS_CU); bf16_t* Qb = (bf16_t*)(ws + WS_Q); bf16_t* Kb = (bf16_t*)(ws + WS_K); bf16_t* Vb = (bf16_t*)(ws + WS_V);
    bf16_t* Gb = (bf16_t*)(ws + WS_G); bf16_t* Tb = (bf16_t*)(ws + WS_T); bf16_t* MMb = (bf16_t*)(ws + WS_MM); bf16_t* H1B = (bf16_t*)(ws + WS_H1B); bf16_t* ACT = (bf16_t*)(ws + WS_ACT);
    bf16_t* HB = (bf16_t*)ob; bf16_t* Ub = (bf16_t*)(ob + OUT_U); bf16_t* Ob = (bf16_t*)(ob + OUT_O);
    const int lo = args.ph_lo, hi = args.ph_hi;
#define IN(k) (lo <= (k) && (k) < hi)
#define SEAM(k) do { if (IN(k) && IN((k) + 1)) xcd_barrier(xbar); } while (0)
    volatile LAS unsigned* xst = (volatile LAS unsigned*)(lds + 143360);
    if (tid == 0) { xst[0] = 0u; xst[1] = 0u; }
    __syncthreads();
    const XcdBarrier xbar = xcd_barrier_post((unsigned*)(ws + WS_BAR), xst);

    if (IN(0)) {
        LAS float* scr = (LAS float*)(lds + wave * 16384);
        const int gw = vcu * NWAVES + wave, NGW = G * NWAVES;
        constexpr int I_IN = 16 * (NIN / 32);
        for (int it = gw; it < I_IN; it += NGW) { const int nblk = NIN / 32, kb = it / nblk, nb = it % nblk; p0_transpose_item(w_in, DM, NIN, WIN, 64 * kb, 32 * nb, map_win(32 * nb), norm1_g, scr, lane); }
        for (int m = gw; m < MFULL; m += 2 * NGW) {
            const int m2 = m + NGW; const bool two = m2 < MFULL; const int mb = two ? m2 : m;
            const int b1 = m / LTOK, t1 = m % LTOK, b2 = mb / LTOK, t2 = mb % LTOK;
            const float* s1 = t1 < NMETA ? meta + (size_t)t1 * DM : x + ((size_t)b1 * SEQ + (t1 - NMETA)) * DM;
            const float* s2 = t2 < NMETA ? meta + (size_t)t2 * DM : x + ((size_t)b2 * SEQ + (t2 - NMETA)) * DM;
            const f32x4* xr1 = (const f32x4*)s1 + lane; const f32x4* xr2 = (const f32x4*)s2 + lane; f32x4 v[4], w[4]; float sa = 0.f, sb2 = 0.f;
#pragma unroll
            for (int j = 0; j < 4; ++j) { v[j] = __builtin_nontemporal_load(xr1 + 64 * j); w[j] = __builtin_nontemporal_load(xr2 + 64 * j); }
#pragma unroll
            for (int j = 0; j < 4; ++j) { sa += (v[j].x * v[j].x + v[j].y * v[j].y) + (v[j].z * v[j].z + v[j].w * v[j].w); sb2 += (w[j].x * w[j].x + w[j].y * w[j].y) + (w[j].z * w[j].z + w[j].w * w[j].w); }
            const float ra = 1.0f / sqrtf(wave_sum(sa) * (1.0f / DM) + EPS), rb = 1.0f / sqrtf(wave_sum(sb2) * (1.0f / DM) + EPS);
            u32x2* o1 = (u32x2*)(HB + (size_t)m * DM) + lane; u32x2* o2 = (u32x2*)(HB + (size_t)mb * DM) + lane;
#pragma unroll
            for (int j = 0; j < 4; ++j) o1[64 * j] = (u32x2){pk2(v[j].x * ra, v[j].y * ra), pk2(v[j].z * ra, v[j].w * ra)};
            if (two) {
#pragma unroll
                for (int j = 0; j < 4; ++j) o2[64 * j] = (u32x2){pk2(w[j].x * rb, w[j].y * rb), pk2(w[j].z * rb, w[j].w * rb)}; }
        }
        for (int i = bx * (NWAVES * 64) + tid; i < MC; i += G * NWAVES * 64) SSQ[i] = 0.f;
    }
    SEAM(0);

    if (IN(1)) {
        pg8::Gemm g{HB, WIN, MFULL, NIN, DM, HB, WIN, DM}; pg8::StaticOrder S; S.init(MFULL, NIN, G, bx);
        LAS float* cst = (LAS float*)(lds + pg8::STAGE_BYTES);
        for (int i = tid; i < 128 + 2048; i += NWAVES * 64) cst[i] = i < 64 ? q_norm_g[i] : (i < 128 ? k_norm_g[i - 64] : b_gate[i - 128]);
        __syncthreads();
        pg8::EpiP1 E{XB, CU, Qb, Kb, Vb, Gb, cst};
        pg8::gemm_phase<pg8::EpiP1, pg8::StaticOrder, true, true>(lds, g, S, E);
        const int NLAST = ((MFULL / 256) * (NIN / 256)) % G;
        if (bx >= NLAST) {
            LAS float* scr = (LAS float*)(lds + wave * 16384);
            const int gw2 = (bx - NLAST) * NWAVES + wave, NGW2 = (G - NLAST) * NWAVES;
            constexpr int I_SQ = 16 * 32, I_FI = 16 * (NFF2 / 32), I_FO = (DFF / 64) * 32, NIT = 3 * I_SQ + I_FI + I_FO;
            for (int it = gw2; it < NIT; it += NGW2) {
                int r = it;
                if (r < 3 * I_SQ) { const int w = r / I_SQ, rr = r % I_SQ, kb = rr / 32, nb = rr % 32; const float* W = w == 0 ? w_conv_out : (w == 1 ? w_sb_out : w_o); bf16_t* WT = w == 0 ? WC : (w == 1 ? WSB : WO);
                    p0_transpose_item(W, DM, DM, WT, 64 * kb, 32 * nb, 32 * nb, nullptr, scr, lane); continue; } r -= 3 * I_SQ;
                if (r < I_FI) { const int nblk = NFF2 / 32, kb = r / nblk, nb = r % nblk; p0_transpose_item(w_ffn_in, DM, NFF2, WFI, 64 * kb, 32 * nb, map_wfi(32 * nb), norm2_g, scr, lane); continue; } r -= I_FI;
                { const int kb = r / 32, nb = r % 32; p0_transpose_item(w_ffn_out, DFF, DM, WFO, 64 * kb, 32 * nb, 32 * nb, nullptr, scr, lane); }
            }
        }
    }
    SEAM(1);

    if (IN(2)) {
        for (int p = vcu; p < NB * 16; p += G)
            for (int j = 7; j >= 0; --j) sb::attn_unit(p >> 4, p & 15, j, Qb, Kb, Vb, Ob, lds);
        for (int item = bx * (NWAVES * 64) + tid; item < (MC / 16) * 128; item += G * NWAVES * 64) {
            const int c0 = (item & 127) * 8, crow0 = (item >> 7) * 16; const int m0 = crow0 + ((crow0 >> 11) + 1) * NMETA;
            f32x4 w0a = *(const f32x4*)(conv_w + c0), w0b = *(const f32x4*)(conv_w + c0 + 4), w1a = *(const f32x4*)(conv_w + DM + c0), w1b = *(const f32x4*)(conv_w + DM + c0 + 4),
                  w2a = *(const f32x4*)(conv_w + 2 * DM + c0), w2b = *(const f32x4*)(conv_w + 2 * DM + c0 + 4);
            f32x4 p2a, p2b, p1a, p1b;
            pg8::unpack8(*(const u32x4*)(CU + (size_t)(m0 - 2) * DM + c0), p2a, p2b); pg8::unpack8(*(const u32x4*)(CU + (size_t)(m0 - 1) * DM + c0), p1a, p1b);
#pragma unroll 4
            for (int i = 0; i < 16; ++i) { f32x4 ca, cb, xa, xbv;
                pg8::unpack8(__builtin_nontemporal_load((const u32x4*)(CU + (size_t)(m0 + i) * DM + c0)), ca, cb); pg8::unpack8(__builtin_nontemporal_load((const u32x4*)(XB + (size_t)(m0 + i) * DM + c0)), xa, xbv);
                const f32x4 ua = xa * (w0a * p2a + w1a * p1a + w2a * ca), ub = xbv * (w0b * p2b + w1b * p1b + w2b * cb);
                *(u32x4*)(Ub + (size_t)(crow0 + i) * DM + c0) = pg8::pack8(ua, ub);
                p2a = p1a; p2b = p1b; p1a = ca; p1b = cb; }
        }
    }
    SEAM(2);

    if (IN(3)) {
        pg8::StaticOrder S; S.init(MC, DM, G, bx);
        pg8::Gemm g{Ub, WC, MC, DM, 2 * DM, Ob, WSB, DM}; pg8::EpiMerged E{Gb, MMb};
        pg8::gemm_phase<pg8::EpiMerged, pg8::StaticOrder, true, true>(lds, g, S, E);
    }
    SEAM(3);

    if (IN(4)) {
        pg8::Gemm g{MMb, WO, MC, DM, DM, MMb, WO, DM}; pg8::StaticOrder S; S.init(MC, DM, G, bx);
        pg8::EpiH1 E{x, H1B, SSQ};
        pg8::gemm_phase<pg8::EpiH1, pg8::StaticOrder, true, true>(lds, g, S, E);
    }
    SEAM(4);

    if (IN(5)) {
        pg8::Gemm g{H1B, WFI, MC, NFF2, DM, H1B, WFI, DM}; pg8::StaticOrder S; S.init(MC, NFF2, G, bx);
        pg8::EpiF1 E{SSQ, ACT, (LAS float*)(lds + pg8::STAGE_BYTES)};
        pg8::gemm_phase<pg8::EpiF1, pg8::StaticOrder, true, true>(lds, g, S, E);
    }
    SEAM(5);

    if (IN(6)) {
        pg8::Gemm g{ACT, WFO, MC, DM, DFF, ACT, WFO, DFF}; pg8::StaticOrder S; S.init(MC, DM, G, bx);
        pg8::EpiOut E{H1B, args.out};
        pg8::gemm_phase<pg8::EpiOut, pg8::StaticOrder, true, true>(lds, g, S, E);
    }
    if (lo < 0) grid.sync();
#undef IN
#undef SEAM
}

extern "C" void kernel_launch(void* const* d_in, const int* in_sizes, int n_in, void* d_out, int out_size, void* d_ws, size_t ws_size, hipStream_t stream) {
    static int grid = 0;
    if (grid == 0) {
        if (n_in != 14 || out_size != MC * DM || ws_size < WS_END) { fprintf(stderr, "kernel_launch: unexpected shapes (n_in %d, out %d, ws %zu < %zu)\n", n_in, out_size, ws_size, (size_t)WS_END); grid = -1; return; }
        int dev = 0, cus = 0, per_cu = 0;
        hipGetDevice(&dev); hipDeviceGetAttribute(&cus, hipDeviceAttributeMultiprocessorCount, dev);
        if (hipFuncSetAttribute((const void*)fwd_megakernel, hipFuncAttributeMaxDynamicSharedMemorySize, LDS_BYTES) != hipSuccess) { fprintf(stderr, "kernel_launch: hipFuncSetAttribute failed\n"); grid = -1; return; }
        if (hipOccupancyMaxActiveBlocksPerMultiprocessor(&per_cu, (const void*)fwd_megakernel, NWAVES * 64, LDS_BYTES) != hipSuccess || per_cu < 1) { fprintf(stderr, "kernel_launch: occupancy query says %d\n", per_cu); per_cu = 1; }
        (void)hipGetLastError();
        grid = cus * 1;
    }
    if (grid < 0) return;
    if (hipMemsetAsync((char*)d_ws + WS_BAR, 0, 16384, stream) != hipSuccess) { fprintf(stderr, "kernel_launch: memset of the barrier words failed\n"); return; }
    Args a{};
    for (int i = 0; i < 14; ++i) a.in[i] = (const float*)d_in[i];
    a.out = (float*)d_out; a.ws = (unsigned char*)d_ws;
#if MK_N_LAUNCHES == 1
    a.ph_lo = 0; a.ph_hi = N_PHASES;
    void* kargs[] = {&a};
    hipError_t e = hipLaunchCooperativeKernel((const void*)fwd_megakernel, dim3(grid), dim3(NWAVES * 64), kargs, LDS_BYTES, stream);
    if (e != hipSuccess) fprintf(stderr, "kernel_launch: cooperative launch failed: %s (grid %d)\n", hipGetErrorString(e), grid);
#else
    for (int p = 0; p < N_PHASES; ++p) { a.ph_lo = p; a.ph_hi = p + 1; hipLaunchKernelGGL(fwd_megakernel, dim3(grid), dim3(NWAVES * 64), LDS_BYTES, stream, a); }
#endif
}
```

```cpp
#include <hip/hip_runtime.h>
#include <hip/hip_cooperative_groups.h>
#include <cstdio>
#include <cstdint>
namespace cg = cooperative_groups;

#ifndef MK_N_LAUNCHES
#define MK_N_LAUNCHES 1
#endif

#define LAS __attribute__((address_space(3)))
typedef unsigned short bf16_t;
typedef short bf16x8 __attribute__((ext_vector_type(8)));
typedef float f32x4 __attribute__((ext_vector_type(4)));
typedef float f32x16 __attribute__((ext_vector_type(16)));
typedef unsigned u32x4 __attribute__((ext_vector_type(4)));
typedef unsigned u32x2 __attribute__((ext_vector_type(2)));

constexpr int DM = 1024, NB = 32, SEQ = 2048, NMETA = 16, LTOK = SEQ + NMETA;
constexpr int MFULL = NB * LTOK;
constexpr int MC = NB * SEQ;
constexpr int NIN = 8192, DFF = 2816, NFF2 = 2 * DFF;
constexpr float EPS = 1e-6f;
constexpr float LOG2E = 1.4426950408889634f;
constexpr float C2 = 0.125f * LOG2E;

constexpr size_t MiB = 1u << 20;
constexpr size_t WS_BAR = 0;
constexpr size_t WS_SSQ = 512 * 1024;
constexpr size_t WS_WIN = 1 * MiB;
constexpr size_t WS_WC = 17 * MiB, WS_WS = 19 * MiB, WS_WO = 21 * MiB;
constexpr size_t WS_WFI = 23 * MiB;
constexpr size_t WS_WFO = 34 * MiB;
constexpr size_t WS_XB = 40 * MiB, WS_CU = 169 * MiB, WS_Q = 298 * MiB, WS_K = 427 * MiB, WS_V = 556 * MiB;
constexpr size_t WS_G = 685 * MiB;
constexpr size_t WS_END = 943 * MiB;
constexpr size_t WS_T = WS_Q, WS_MM = WS_K, WS_H1B = WS_V;
constexpr size_t WS_ACT = WS_XB;
constexpr size_t OUT_U = 0, OUT_O = 128 * MiB;

namespace pg8 {
constexpr int BM = 256, BK = 64, HALF = 128, HTB = HALF * BK * 2, STAGE_BYTES = 8 * HTB, NXCD = 8, WGM = 8;
__host__ __device__ __forceinline__ int lds_byte(int r, int c) { const int st = (r >> 4) * 2 + (c >> 5), rr = r & 15, cc = c & 31, ob = rr * 64 + cc * 2; return st * 1024 + (ob ^ (((ob >> 9) & 1) << 5)); }
__host__ __device__ __forceinline__ void stage_rc(int b, int& R, int& C) { const int st = b / 1024, sb = b % 1024, swz = sb ^ (((sb >> 9) & 1) << 5); R = (st >> 1) * 16 + swz / 64; C = (st & 1) * 32 + (swz % 64) / 2; }
__host__ __device__ __forceinline__ int perm32(int rho) { const int n = rho >> 4, i = rho & 15; return 8 * (i >> 2) + 4 * n + (i & 3); }

struct Unit { int pm, pn; };
struct Gemm { const bf16_t* A; const bf16_t* Bt; int M, N, K; const bf16_t* A2; const bf16_t* Bt2; int K1; };

struct StaticOrder {
    int nM, nN, nwg, G, c;
    __host__ __device__ void init(int M, int N, int G_, int c_) { nM = M / BM; nN = N / BM; nwg = nM * nN; G = G_; c = c_; }
    __host__ __device__ bool next(int i, Unit& u) const {
        const long L = (long)i * G + c; if (L >= nwg) return false;
        int wgid = (int)L; { const int q = nwg / NXCD, r = nwg % NXCD, xcd = wgid % NXCD, off = wgid / NXCD; wgid = (xcd < r ? xcd * (q + 1) : r * (q + 1) + (xcd - r) * q) + off; }
        const int nig = WGM * nN, gid = wgid / nig, fm = gid * WGM, gsz = (nM - fm) < WGM ? (nM - fm) : WGM;
        u.pm = fm + ((wgid % nig) % gsz); u.pn = (wgid % nig) / gsz; return true;
    }
};

typedef float f32x2_t __attribute__((ext_vector_type(2))); typedef __bf16 bf16x2_t __attribute__((ext_vector_type(2)));
__device__ __forceinline__ unsigned cvt_pk_bf16(float lo, float hi) { const f32x2_t v = {lo, hi}; const bf16x2_t b = __builtin_convertvector(v, bf16x2_t); return __builtin_bit_cast(unsigned, b); }
__device__ __forceinline__ u32x4 pack8(const f32x4 a, const f32x4 b) { u32x4 w; w.x = cvt_pk_bf16(a[0], a[1]); w.y = cvt_pk_bf16(a[2], a[3]); w.z = cvt_pk_bf16(b[0], b[1]); w.w = cvt_pk_bf16(b[2], b[3]); return w; }
__device__ __forceinline__ void unpack8(const u32x4 w, f32x4& a, f32x4& b) {
    a[0] = __uint_as_float(w.x << 16); a[1] = __uint_as_float(w.x & 0xffff0000u); a[2] = __uint_as_float(w.y << 16); a[3] = __uint_as_float(w.y & 0xffff0000u);
    b[0] = __uint_as_float(w.z << 16); b[1] = __uint_as_float(w.z & 0xffff0000u); b[2] = __uint_as_float(w.w << 16); b[3] = __uint_as_float(w.w & 0xffff0000u);
}
__device__ __forceinline__ float sigmoidf_fast(float x) { return __builtin_amdgcn_rcpf(1.0f + __builtin_amdgcn_exp2f(-LOG2E * x)); }

struct EpiP1 {
    static constexpr bool PERM = true, AFTER_DRAIN = false, HAS_MID = false, HAS_PRE = false;
    bf16_t *XB, *CU, *Q, *K, *V, *G; const LAS float* cst;
    __device__ __forceinline__ void operator()(const f32x4 (&acc)[2][2][4][2], const Unit& u, int wr, int wc, int fr, int fq) const {
        const int row0 = u.pm * BM + wr * 64 + fr; const int pn = u.pn;
        if (pn < 4 || (pn >= 20 && pn < 24)) {
            bf16_t* base = (pn < 4 ? XB : V) + (pn & 3) * 256 + wc * 32 + 8 * fq;
#pragma unroll
            for (int ai = 0; ai < 2; ++ai)
#pragma unroll
                for (int m = 0; m < 4; ++m) { const int row = row0 + ai * HALF + m * 16; bf16_t* rowp = base + (size_t)row * DM;
#pragma unroll
                    for (int bj = 0; bj < 2; ++bj) *(u32x4*)(rowp + bj * HALF) = pack8(acc[ai][bj][m][0], acc[ai][bj][m][1]); }
        } else if (pn < 12) {
            bf16_t* base = CU + (pn - 4) * 128 + wc * 32 + 8 * fq;
#pragma unroll
            for (int ai = 0; ai < 2; ++ai)
#pragma unroll
                for (int m = 0; m < 4; ++m) { const int row = row0 + ai * HALF + m * 16;
                    *(u32x4*)(base + (size_t)row * DM) = pack8(acc[ai][0][m][0] * acc[ai][1][m][0], acc[ai][0][m][1] * acc[ai][1][m][1]); }
        } else if (pn < 20) {
            const bool isq = pn < 16; const int head = ((pn - 12) & 3) * 4 + wc; bf16_t* base = (isq ? Q : K) + head * 64 + 8 * fq; const LAS float* gp = cst + (isq ? 0 : 64) + 8 * fq; const float post = isq ? C2 : 1.0f;
            f32x4 gv[2][2];
#pragma unroll
            for (int bj = 0; bj < 2; ++bj)
#pragma unroll
                for (int n = 0; n < 2; ++n) gv[bj][n] = *(const LAS f32x4*)(gp + 32 * bj + 4 * n);
#pragma unroll
            for (int ai = 0; ai < 2; ++ai)
#pragma unroll
                for (int m = 0; m < 4; ++m) { const int row = row0 + ai * HALF + m * 16; float ss = 0.f;
#pragma unroll
                    for (int bj = 0; bj < 2; ++bj)
#pragma unroll
                        for (int n = 0; n < 2; ++n) { const f32x4 x = acc[ai][bj][m][n]; ss += (x[0] * x[0] + x[1] * x[1]) + (x[2] * x[2] + x[3] * x[3]); }
                    ss += __shfl_xor(ss, 16); ss += __shfl_xor(ss, 32);
                    const float rr = __builtin_amdgcn_rsqf(ss * (1.0f / 64.0f) + EPS) * post;
#pragma unroll
                    for (int bj = 0; bj < 2; ++bj) *(u32x4*)(base + (size_t)row * DM + 32 * bj) = pack8(acc[ai][bj][m][0] * rr * gv[bj][0], acc[ai][bj][m][1] * rr * gv[bj][1]); }
        } else {
            const int ch0 = (pn - 24) * 128 + wc * 32 + 8 * fq; bf16_t* base = G + ch0;
            f32x4 bv[2][2];
#pragma unroll
            for (int bj = 0; bj < 2; ++bj)
#pragma unroll
                for (int n = 0; n < 2; ++n) bv[bj][n] = *(const LAS f32x4*)(cst + 128 + bj * 1024 + ch0 + 4 * n);
#pragma unroll
            for (int ai = 0; ai < 2; ++ai)
#pragma unroll
                for (int m = 0; m < 4; ++m) { const int row = row0 + ai * HALF + m * 16; f32x4 rt[2], g1[2];
#pragma unroll
                    for (int n = 0; n < 2; ++n) { const f32x4 x0 = acc[ai][0][m][n] + bv[0][n], x1 = acc[ai][1][m][n] + bv[1][n];
#pragma unroll
                        for (int i = 0; i < 4; ++i) { const float d0 = 1.0f + __builtin_amdgcn_exp2f(-LOG2E * x0[i]), d1 = 1.0f + __builtin_amdgcn_exp2f(-LOG2E * x1[i]);
                            rt[n][i] = d1 * __builtin_amdgcn_rcpf(d0); g1[n][i] = __builtin_amdgcn_rcpf(d1); } }
                    *(u32x4*)(base + (size_t)row * 2048) = pack8(rt[0], rt[1]); *(u32x4*)(base + (size_t)row * 2048 + 1024) = pack8(g1[0], g1[1]); }
        }
    }
};
struct EpiMerged {
    static constexpr bool PERM = true, AFTER_DRAIN = false, HAS_MID = true, HAS_PRE = false;
    const bf16_t* G; bf16_t* MMo;
    __device__ __forceinline__ void mid(f32x4 (&acc)[2][2][4][2], const Unit& u, int wr, int wc, int fr, int fq) const {
        const int row0 = u.pm * BM + wr * 64 + fr; const int goff = ((u.pm >> 3) + 1) * NMETA; const int col0 = u.pn * BM + wc * 32 + 8 * fq;
#pragma unroll
        for (int ai = 0; ai < 2; ++ai)
#pragma unroll
            for (int m = 0; m < 4; ++m) { const bf16_t* gp = G + (size_t)(row0 + ai * HALF + m * 16 + goff) * 2048 + col0;
#pragma unroll
                for (int bj = 0; bj < 2; ++bj) { f32x4 a0, a1; unpack8(*(const u32x4*)(gp + bj * HALF), a0, a1); acc[ai][bj][m][0] *= a0; acc[ai][bj][m][1] *= a1; } }
    }
    __device__ __forceinline__ void operator()(const f32x4 (&acc)[2][2][4][2], const Unit& u, int wr, int wc, int fr, int fq) const {
        const int row0 = u.pm * BM + wr * 64 + fr; const int goff = ((u.pm >> 3) + 1) * NMETA; const int col0 = u.pn * BM + wc * 32 + 8 * fq;
#pragma unroll
        for (int ai = 0; ai < 2; ++ai)
#pragma unroll
            for (int m = 0; m < 4; ++m) { const int row = row0 + ai * HALF + m * 16;
#pragma unroll
                for (int bj = 0; bj < 2; ++bj) { const int col = col0 + bj * HALF;
                    f32x4 b0, b1; unpack8(*(const u32x4*)(G + (size_t)(row + goff) * 2048 + 1024 + col), b0, b1);
                    *(u32x4*)(MMo + (size_t)row * DM + col) = pack8(acc[ai][bj][m][0] * b0, acc[ai][bj][m][1] * b1); } }
    }
};
struct EpiH1 {
    static constexpr bool PERM = true, AFTER_DRAIN = false, HAS_MID = false, HAS_PRE = false;
    const float* x; bf16_t* H1B; float* ssq;
    __device__ __forceinline__ void operator()(const f32x4 (&acc)[2][2][4][2], const Unit& u, int wr, int wc, int fr, int fq) const {
        const int row0 = u.pm * BM + wr * 64 + fr; const int col0 = u.pn * BM + wc * 32 + 8 * fq;
#pragma unroll
        for (int ai = 0; ai < 2; ++ai)
#pragma unroll
            for (int m = 0; m < 4; ++m) { const int row = row0 + ai * HALF + m * 16; float ss = 0.f;
#pragma unroll
                for (int bj = 0; bj < 2; ++bj) { const size_t off = (size_t)row * DM + col0 + bj * HALF;
                    const f32x4 a = __builtin_nontemporal_load((const f32x4*)(x + off)) + acc[ai][bj][m][0], b = __builtin_nontemporal_load((const f32x4*)(x + off + 4)) + acc[ai][bj][m][1];
                    *(u32x4*)(H1B + off) = pack8(a, b);
                    ss += (a[0] * a[0] + a[1] * a[1]) + (a[2] * a[2] + a[3] * a[3]) + (b[0] * b[0] + b[1] * b[1]) + (b[2] * b[2] + b[3] * b[3]); }
                ss += __shfl_xor(ss, 16); ss += __shfl_xor(ss, 32);
                if (fq == 0) atomicAdd(ssq + row, ss); }
    }
};
struct EpiF1 {
    static constexpr bool PERM = true, AFTER_DRAIN = false, HAS_MID = false, HAS_PRE = true;
    const float* ssq; bf16_t* ACT; LAS float* slot;
    __device__ __forceinline__ void pre(const Unit& u, int ui, int wid, int lane) const {
        if (wid < 4) __builtin_amdgcn_global_load_lds((const unsigned*)(ssq + u.pm * BM + wid * 64 + lane), (LAS unsigned*)(slot + (ui & 1) * BM + wid * 64), 4, 0, 0);
    }
    __device__ __forceinline__ void operator()(const f32x4 (&acc)[2][2][4][2], const Unit& u, int wr, int wc, int fr, int fq, int ui) const {
        const int col0 = u.pn * 128 + wc * 32 + 8 * fq; const LAS float* sq = slot + (ui & 1) * BM;
#pragma unroll
        for (int ai = 0; ai < 2; ++ai)
#pragma unroll
            for (int m = 0; m < 4; ++m) { const int rl = wr * 64 + fr + ai * HALF + m * 16; const int row = u.pm * BM + rl; const float ri = __builtin_amdgcn_rsqf(sq[rl] * (1.0f / DM) + EPS);
                f32x4 o[2];
#pragma unroll
                for (int n = 0; n < 2; ++n) { const f32x4 g = acc[ai][0][m][n] * ri, up = acc[ai][1][m][n] * ri;
#pragma unroll
                    for (int i = 0; i < 4; ++i) o[n][i] = g[i] * sigmoidf_fast(g[i]) * up[i]; }
                *(u32x4*)(ACT + (size_t)row * DFF + col0) = pack8(o[0], o[1]); }
    }
};
struct EpiOut {
    static constexpr bool PERM = true, AFTER_DRAIN = false, HAS_MID = false, HAS_PRE = false;
    const bf16_t* H1B; float* out;
    __device__ __forceinline__ void operator()(const f32x4 (&acc)[2][2][4][2], const Unit& u, int wr, int wc, int fr, int fq) const {
        const int row0 = u.pm * BM + wr * 64 + fr; const int col0 = u.pn * BM + wc * 32 + 8 * fq;
#pragma unroll
        for (int ai = 0; ai < 2; ++ai)
#pragma unroll
            for (int m = 0; m < 4; ++m) { const int row = row0 + ai * HALF + m * 16;
#pragma unroll
                for (int bj = 0; bj < 2; ++bj) { const size_t off = (size_t)row * DM + col0 + bj * HALF;
                    f32x4 h0, h1; unpack8(__builtin_nontemporal_load((const u32x4*)(H1B + off)), h0, h1);
                    __builtin_nontemporal_store(h0 + acc[ai][bj][m][0], (f32x4*)(out + off)); __builtin_nontemporal_store(h1 + acc[ai][bj][m][1], (f32x4*)(out + off + 4)); } }
    }
};

template <class Epi, class Sched, bool ALIGN_EPI = false, bool SP2 = false>
__device__ __forceinline__ void gemm_phase(LAS unsigned char* lds, const Gemm g, const Sched& S, const Epi& E) {
    const int tid = threadIdx.x, wid = __builtin_amdgcn_readfirstlane(tid >> 6), lane = tid & 63, wr = wid >> 2, wc = wid & 3, fr = lane & 15, fq = lane >> 4;
    const int K = g.K, nt = K / BK, ld = g.K1, nt1 = g.K1 / BK;
    unsigned voffA[2], voffB[2];
#pragma unroll
    for (int i = 0; i < 2; ++i) { int R, C; stage_rc(tid * 16 + i * 8192, R, C); const int Rb = Epi::PERM ? ((R & ~31) + perm32(R & 31)) : R;
        voffA[i] = (unsigned)(R * ld + C) * 2u; voffB[i] = (unsigned)(Rb * ld + C) * 2u; }
    const size_t kstep = (size_t)(BK * 2);
    const size_t hstep = (size_t)HALF * ld * 2;
    const size_t tstep = 2 * hstep;
    const unsigned ldsw = (unsigned)wid * 1024u;
    const int aoff = lds_byte(wr * 64 + fr, fq * 8), boff = lds_byte(wc * 32 + fr, fq * 8);
#define PG8_SA(b, h) (((b) * 2 + (h)) * HTB)
#define PG8_SB(b, h) ((4 + (b) * 2 + (h)) * HTB)
#define PG8_STAGE(bufoff, gbase, voff) do { _Pragma("unroll") for (int _i = 0; _i < 2; ++_i) \
        __builtin_amdgcn_global_load_lds((const unsigned*)((const char*)(gbase) + (voff)[_i]), (LAS unsigned*)(lds + (bufoff) + ldsw + _i * 8192), 16, 0, 0); } while (0)
#define PG8_LDA(dst, b, h) do { _Pragma("unroll") for (int m = 0; m < 4; ++m) _Pragma("unroll") for (int k = 0; k < 2; ++k) dst[m][k] = *(const LAS bf16x8*)(lds + PG8_SA(b, h) + aoff + m * 2048 + k * 1024); } while (0)
#define PG8_LDB(dst, b, h) do { _Pragma("unroll") for (int n = 0; n < 2; ++n) _Pragma("unroll") for (int k = 0; k < 2; ++k) dst[n][k] = *(const LAS bf16x8*)(lds + PG8_SB(b, h) + boff + n * 2048 + k * 1024); } while (0)
#define PG8_MMA(ai, bj, At, Bt) do { __builtin_amdgcn_s_setprio(1); _Pragma("unroll") for (int m = 0; m < 4; ++m) _Pragma("unroll") for (int n = 0; n < 2; ++n) _Pragma("unroll") for (int k = 0; k < 2; ++k) \
        acc[ai][bj][m][n] = __builtin_amdgcn_mfma_f32_16x16x32_bf16(Bt[n][k], At[m][k], acc[ai][bj][m][n], 0, 0, 0); __builtin_amdgcn_s_setprio(0); } while (0)
#define PG8_WAIT_V(n) asm volatile("s_waitcnt vmcnt(" #n ")" ::: "memory")
#define PG8_WAIT_L(n) asm volatile("s_waitcnt lgkmcnt(" #n ")" ::: "memory")
#define PG8_BAR __builtin_amdgcn_s_barrier()
#define PG8_SCHED __builtin_amdgcn_sched_barrier(0)
    Unit cur, nxt; int ui = 0;
    if (!S.next(0, cur)) return;
    f32x4 acc[2][2][4][2];
#pragma unroll
    for (int a = 0; a < 2; ++a)
#pragma unroll
        for (int b = 0; b < 2; ++b)
#pragma unroll
            for (int m = 0; m < 4; ++m)
#pragma unroll
                for (int n = 0; n < 2; ++n) acc[a][b][m][n] = (f32x4){0.f, 0.f, 0.f, 0.f};
    bf16x8 At[4][2], B0[2][2], B1[2][2];
    const char* cA = (const char*)g.A + (size_t)cur.pm * tstep; const char* cB = (const char*)g.Bt + (size_t)cur.pn * tstep;
    if constexpr (Epi::HAS_PRE) E.pre(cur, 0, wid, lane);
    if constexpr (SP2) {
        PG8_STAGE(PG8_SB(0, 0), cB, voffB); PG8_STAGE(PG8_SB(0, 1), cB + hstep, voffB); PG8_STAGE(PG8_SA(0, 0), cA, voffA); PG8_STAGE(PG8_SA(0, 1), cA + hstep, voffA);
        if (wr == 1) PG8_BAR;
        PG8_WAIT_V(2); PG8_BAR;
        PG8_STAGE(PG8_SB(1, 0), cB + kstep, voffB); PG8_STAGE(PG8_SA(1, 0), cA + kstep, voffA); PG8_STAGE(PG8_SB(1, 1), cB + hstep + kstep, voffB);
        PG8_WAIT_V(6); PG8_BAR;
    } else {
        PG8_STAGE(PG8_SB(0, 0), cB, voffB); PG8_STAGE(PG8_SA(0, 0), cA, voffA); PG8_STAGE(PG8_SB(0, 1), cB + hstep, voffB); PG8_STAGE(PG8_SA(0, 1), cA + hstep, voffA);
        if (wr == 1) PG8_BAR;
        PG8_WAIT_V(4); PG8_BAR;
        PG8_STAGE(PG8_SB(1, 0), cB + kstep, voffB); PG8_STAGE(PG8_SA(1, 0), cA + kstep, voffA); PG8_STAGE(PG8_SB(1, 1), cB + hstep + kstep, voffB);
        PG8_WAIT_V(6); PG8_BAR;
    }
    for (;;) {
        const bool has_next = S.next(ui + 1, nxt);
        const char* nA = has_next ? (const char*)g.A + (size_t)nxt.pm * tstep : cA; const char* nB = has_next ? (const char*)g.Bt + (size_t)nxt.pn * tstep : cB;
        for (int t = 0; t < nt; t += 2) {
            const bool last = (t == nt - 2);
            const char* a1 = t < nt1 ? cA + (size_t)(t + 1) * kstep : (const char*)g.A2 + (size_t)cur.pm * tstep + (size_t)(t + 1 - nt1) * kstep;
            const char* a2 = last ? nA : (t + 2 < nt1 ? cA + (size_t)(t + 2) * kstep : (const char*)g.A2 + (size_t)cur.pm * tstep + (size_t)(t + 2 - nt1) * kstep);
            const char* b2 = last ? nB : (t + 2 < nt1 ? cB + (size_t)(t + 2) * kstep : (const char*)g.Bt2 + (size_t)cur.pn * tstep + (size_t)(t + 2 - nt1) * kstep);
            const char* a3 = a2 + kstep; const char* b3 = b2 + kstep;
            if constexpr (SP2) {
            PG8_LDB(B0, 0, 0); PG8_LDB(B1, 0, 1); PG8_SCHED; PG8_LDA(At, 0, 0); PG8_STAGE(PG8_SA(1, 1), a1 + hstep, voffA);
            PG8_WAIT_V(8); PG8_WAIT_L(0); PG8_BAR; PG8_MMA(0, 0, At, B0); PG8_MMA(0, 1, At, B1); PG8_BAR; PG8_SCHED;
            PG8_LDA(At, 0, 1); PG8_STAGE(PG8_SB(0, 0), b2, voffB); PG8_STAGE(PG8_SB(0, 1), b2 + hstep, voffB); PG8_STAGE(PG8_SA(0, 0), a2, voffA);
            PG8_WAIT_V(8); PG8_WAIT_L(0); PG8_BAR; PG8_MMA(1, 0, At, B0); PG8_MMA(1, 1, At, B1); PG8_BAR; PG8_SCHED;
            PG8_LDB(B0, 1, 0); PG8_LDB(B1, 1, 1); PG8_SCHED; PG8_LDA(At, 1, 0); PG8_STAGE(PG8_SA(0, 1), a2 + hstep, voffA);
            PG8_WAIT_V(8); PG8_WAIT_L(0); PG8_BAR; PG8_MMA(0, 0, At, B0); PG8_MMA(0, 1, At, B1); PG8_BAR; PG8_SCHED;
            PG8_LDA(At, 1, 1); PG8_STAGE(PG8_SB(1, 0), b3, voffB); PG8_STAGE(PG8_SB(1, 1), b3 + hstep, voffB); PG8_STAGE(PG8_SA(1, 0), a3, voffA);
            PG8_WAIT_V(8); PG8_WAIT_L(0); PG8_BAR; PG8_MMA(1, 0, At, B0); PG8_MMA(1, 1, At, B1); PG8_BAR; PG8_SCHED;
            } else {
            PG8_LDB(B0, 0, 0); PG8_SCHED; PG8_LDA(At, 0, 0); PG8_STAGE(PG8_SA(1, 1), a1 + hstep, voffA);
            PG8_WAIT_L(8); PG8_BAR; PG8_WAIT_L(0); PG8_MMA(0, 0, At, B0); PG8_BAR; PG8_SCHED;
            PG8_LDB(B1, 0, 1); PG8_STAGE(PG8_SB(0, 0), b2, voffB);
            PG8_BAR; PG8_WAIT_L(0); PG8_MMA(0, 1, At, B1); PG8_BAR;
            PG8_LDA(At, 0, 1); PG8_STAGE(PG8_SA(0, 0), a2, voffA);
            PG8_BAR; PG8_WAIT_L(0); PG8_MMA(1, 0, At, B0); PG8_BAR; PG8_SCHED;
            PG8_STAGE(PG8_SB(0, 1), b2 + hstep, voffB);
            PG8_WAIT_V(6); PG8_BAR; PG8_MMA(1, 1, At, B1); PG8_BAR;
            PG8_LDB(B0, 1, 0); PG8_SCHED; PG8_LDA(At, 1, 0); PG8_STAGE(PG8_SA(0, 1), a2 + hstep, voffA);
            PG8_WAIT_L(8); PG8_BAR; PG8_WAIT_L(0); PG8_MMA(0, 0, At, B0); PG8_BAR; PG8_SCHED;
            PG8_LDB(B1, 1, 1); PG8_STAGE(PG8_SB(1, 0), b3, voffB);
            PG8_BAR; PG8_WAIT_L(0); PG8_MMA(0, 1, At, B1); PG8_BAR;
            PG8_LDA(At, 1, 1); PG8_STAGE(PG8_SA(1, 0), a3, voffA);
            PG8_BAR; PG8_WAIT_L(0); PG8_MMA(1, 0, At, B0); PG8_BAR; PG8_SCHED;
            PG8_STAGE(PG8_SB(1, 1), b3 + hstep, voffB);
            PG8_WAIT_V(6); PG8_BAR; PG8_MMA(1, 1, At, B1); PG8_BAR;
            }
            if constexpr (Epi::HAS_MID) { if (t + 2 == nt1) E.mid(acc, cur, wr, wc, fr, fq); }
        }
        if constexpr (ALIGN_EPI) { if (wr == 0) PG8_BAR; }
        if constexpr (Epi::HAS_PRE) { E(acc, cur, wr, wc, fr, fq, ui); if (has_next) E.pre(nxt, ui + 1, wid, lane); }
        else E(acc, cur, wr, wc, fr, fq);
        if (!has_next) break;
#pragma unroll
        for (int a = 0; a < 2; ++a)
#pragma unroll
            for (int b = 0; b < 2; ++b)
#pragma unroll
                for (int m = 0; m < 4; ++m)
#pragma unroll
                    for (int n = 0; n < 2; ++n) acc[a][b][m][n] = (f32x4){0.f, 0.f, 0.f, 0.f};
        cur = nxt; cA = nA; cB = nB; ++ui;
        if constexpr (ALIGN_EPI) { if (wr == 1) PG8_BAR; }
    }
    PG8_WAIT_V(0);
    if constexpr (!ALIGN_EPI) { if (wr == 0) PG8_BAR; }
    PG8_BAR;
#undef PG8_SA
#undef PG8_SB
#undef PG8_STAGE
#undef PG8_LDA
#undef PG8_LDB
#undef PG8_MMA
#undef PG8_WAIT_V
#undef PG8_WAIT_L
#undef PG8_BAR
#undef PG8_SCHED
}
}

namespace sb {
constexpr int KBUF = 8192, LDS_V0 = 2 * KBUF;
__device__ __forceinline__ unsigned cvtpk(float lo, float hi) { return pg8::cvt_pk_bf16(lo, hi); }
typedef short v4i16_t __attribute__((ext_vector_type(4)));
__device__ __forceinline__ v4i16_t vtr(const LAS unsigned char* p) { return __builtin_amdgcn_ds_read_tr16_b64_v4i16((LAS v4i16_t*)p); }

__device__ __forceinline__ void qk_tile(f32x16& p0, f32x16& p1, const LAS unsigned char* Kb, const bf16x8 (&qr)[4]) {
    bf16x8 kf[8];
#pragma unroll
    for (int d0 = 0; d0 < 4; ++d0) { kf[2 * d0] = *(const LAS bf16x8*)(Kb + d0 * 2048); kf[2 * d0 + 1] = *(const LAS bf16x8*)(Kb + d0 * 2048 + 512); }
    __builtin_amdgcn_sched_barrier(0);
    p0 = (f32x16){}; p1 = (f32x16){};
#pragma unroll
    for (int d0 = 0; d0 < 4; ++d0) p0 = __builtin_amdgcn_mfma_f32_32x32x16_bf16(kf[2 * d0], qr[d0], p0, 0, 0, 0);
#pragma unroll
    for (int d0 = 0; d0 < 4; ++d0) p1 = __builtin_amdgcn_mfma_f32_32x32x16_bf16(kf[2 * d0 + 1], qr[d0], p1, 0, 0, 0);
}
__device__ __forceinline__ void v_frags(bf16x8 (&vf)[8], const LAS unsigned char* Vb) {
#pragma unroll
    for (int ks = 0; ks < 4; ++ks) { const int ko = ((ks >> 1) * 4 + (ks & 1)) * 512;
        { const v4i16_t lo = vtr(Vb + ko), hh = vtr(Vb + ko + 256); vf[ks] = (bf16x8){lo[0], lo[1], lo[2], lo[3], hh[0], hh[1], hh[2], hh[3]}; }
        { const v4i16_t lo = vtr(Vb + 4096 + ko), hh = vtr(Vb + 4096 + ko + 256); vf[4 + ks] = (bf16x8){lo[0], lo[1], lo[2], lo[3], hh[0], hh[1], hh[2], hh[3]}; } }
}
typedef float f32x2 __attribute__((ext_vector_type(2)));
__device__ __forceinline__ void sb_weights(f32x16& p0, f32x16& p1, float& carry, u32x4 (&pw)[4], bool diag, int t, int kb, int hi) {
    if (diag) {
#pragma unroll
        for (int r = 0; r < 16; ++r) { if (kb + r >= t) p0[r] = -INFINITY; if (kb + 32 + r >= t) p1[r] = -INFINITY; }
    }
    f32x2 u[16], tg[4];
#pragma unroll
    for (int g = 0; g < 4; ++g) {
        f32x2 e0, e1, e2, e3;
        e0.x = __builtin_amdgcn_exp2f(p0[4 * g]);     e0.y = __builtin_amdgcn_exp2f(p1[4 * g]);
        e1.x = __builtin_amdgcn_exp2f(p0[4 * g + 1]); e1.y = __builtin_amdgcn_exp2f(p1[4 * g + 1]);
        e2.x = __builtin_amdgcn_exp2f(p0[4 * g + 2]); e2.y = __builtin_amdgcn_exp2f(p1[4 * g + 2]);
        e3.x = __builtin_amdgcn_exp2f(p0[4 * g + 3]); e3.y = __builtin_amdgcn_exp2f(p1[4 * g + 3]);
        const f32x2 d0 = e0 + 1.0f, d1 = e1 + 1.0f, d2 = e2 + 1.0f, d3 = e3 + 1.0f;
        const f32x2 q1 = d0 * d1, q2 = q1 * d2, dd = q2 * d3;
        tg[g].x = __builtin_amdgcn_rcpf(dd.x); tg[g].y = __builtin_amdgcn_rcpf(dd.y);
        u[4 * g] = e0; u[4 * g + 1] = d0 * e1; u[4 * g + 2] = q1 * e2; u[4 * g + 3] = q2 * e3;
    }
    const f32x2 TT = (tg[0] * tg[1]) * (tg[2] * tg[3]);
    const float T0 = TT.x, T1 = TT.y;
    const auto s0 = __builtin_amdgcn_permlane32_swap(__float_as_uint(T0), __float_as_uint(T0), false, false);
    const auto s1 = __builtin_amdgcn_permlane32_swap(__float_as_uint(T1), __float_as_uint(T1), false, false);
    const float T0lo = __uint_as_float(s0[0]), T0hi = __uint_as_float(s0[1]), T1lo = __uint_as_float(s1[0]), T1hi = __uint_as_float(s1[1]);
    const float cW1 = carry * (T1lo * T1hi);
    const float E1 = hi ? carry : carry * T1hi;
    const float E0 = hi ? cW1 : cW1 * T0hi;
    carry = cW1 * (T0lo * T0hi);
    f32x2 y = {E0, E1};
#pragma unroll
    for (int g = 3; g >= 0; --g) { y *= tg[g];
#pragma unroll
        for (int k = 0; k < 4; ++k) u[4 * g + k] *= y; }
    pw[0] = (u32x4){cvtpk(u[0].x, u[1].x), cvtpk(u[2].x, u[3].x), cvtpk(u[4].x, u[5].x), cvtpk(u[6].x, u[7].x)};
    pw[1] = (u32x4){cvtpk(u[8].x, u[9].x), cvtpk(u[10].x, u[11].x), cvtpk(u[12].x, u[13].x), cvtpk(u[14].x, u[15].x)};
    pw[2] = (u32x4){cvtpk(u[0].y, u[1].y), cvtpk(u[2].y, u[3].y), cvtpk(u[4].y, u[5].y), cvtpk(u[6].y, u[7].y)};
    pw[3] = (u32x4){cvtpk(u[8].y, u[9].y), cvtpk(u[10].y, u[11].y), cvtpk(u[12].y, u[13].y), cvtpk(u[14].y, u[15].y)};
}

__device__ __forceinline__ void attn_unit(int b, int h, int j, const bf16_t* __restrict__ Q, const bf16_t* __restrict__ K, const bf16_t* __restrict__ V, bf16_t* __restrict__ O, LAS unsigned char* lds) {
    const int tid = threadIdx.x, lane = tid & 63, r32 = lane & 31, hi = lane >> 5; const int wid = __builtin_amdgcn_readfirstlane(tid >> 6);
    const long rowbase = (long)b * LTOK;
    const int t0 = NMETA + 256 * j + 32 * wid;
    const int c_top = 4 * j + 4, c_hi = (t0 + 30) >> 6;
    bf16x8 qr[4];
    { const bf16_t* Qw = Q + (rowbase + t0 + r32) * DM + h * 64 + hi * 8;
#pragma unroll
      for (int d0 = 0; d0 < 4; ++d0) qr[d0] = *(const bf16x8*)(Qw + d0 * 16); }
    const int skey = 8 * wid + (lane >> 3), sch = lane & 7;
    const bf16_t* kcol = K + h * 64 + sch * 8; const bf16_t* vcol = V + h * 64 + sch * 8;
    const unsigned ksoff = (unsigned)sch * 1024u + (unsigned)skey * 16u;
    const unsigned vsoff = (unsigned)(sch >> 2) * 4096u + (unsigned)wid * 512u + (unsigned)(lane >> 3) * 64u + (unsigned)(sch & 3) * 16u;
    u32x4 kE, vE, kO, vO;
    const bf16_t* kp = kcol + (rowbase + skey) * DM; const bf16_t* vp = vcol + (rowbase + skey) * DM;
#define SB_LOADC(c, KR, VR) do { int kk = (c) * 64 + skey; kk = kk < LTOK ? kk : LTOK - 1; \
        KR = *(const u32x4*)(kcol + (rowbase + kk) * DM); VR = *(const u32x4*)(vcol + (rowbase + kk) * DM); } while (0)
#define SB_LOAD(c, KR, VR) do { const long to_ = (long)__builtin_amdgcn_readfirstlane(c) * (64 * DM); KR = *(const u32x4*)(kp + to_); VR = *(const u32x4*)(vp + to_); } while (0)
#define SB_STORE(buf, KR, VR) do { *(LAS u32x4*)(lds + (buf) * KBUF + ksoff) = KR; *(LAS u32x4*)(lds + LDS_V0 + (buf) * KBUF + vsoff) = VR; } while (0)
    SB_LOADC(c_top, kE, vE); SB_LOADC(c_top - 1, kO, vO); SB_STORE(0, kE, vE);
    __syncthreads();
    f32x16 o0 = {}, o1 = {}; float carry = 1.0f;
    const int kperm = 16 * ((r32 >> 2) & 1) + (r32 & 3) + 4 * (r32 >> 3);
    const unsigned kfo = (unsigned)hi * 1024u + (unsigned)kperm * 16u;
    const unsigned vfo = (unsigned)LDS_V0 + (unsigned)(2 * hi) * 512u + (unsigned)((lane & 15) >> 2) * 64u + (unsigned)((lane >> 4) & 1) * 32u + (unsigned)(lane & 3) * 8u;
    const int tq = t0 + r32;
#define SB_COMPUTE(c, buf) do { if ((c) <= c_hi) { f32x16 p0, p1; bf16x8 vf[8]; u32x4 pw[4]; \
            qk_tile(p0, p1, lds + (buf) * KBUF + kfo, qr); v_frags(vf, lds + (buf) * KBUF + vfo); __builtin_amdgcn_sched_barrier(0); \
            sb_weights(p0, p1, carry, pw, (c) * 64 + 63 >= t0, tq, (c) * 64 + 16 * hi, hi); \
            _Pragma("unroll") for (int kk = 0; kk < 4; ++kk) { const int ks = (kk + 2) & 3;     \
                o0 = __builtin_amdgcn_mfma_f32_32x32x16_bf16(__builtin_bit_cast(bf16x8, pw[ks]), vf[ks], o0, 0, 0, 0); \
                o1 = __builtin_amdgcn_mfma_f32_32x32x16_bf16(__builtin_bit_cast(bf16x8, pw[ks]), vf[4 + ks], o1, 0, 0, 0); } } } while (0)
    for (int c = c_top; c >= 0; c -= 2) {
        if (c >= 2) SB_LOAD(c - 2, kE, vE);
        SB_COMPUTE(c, 0);
        if (c >= 1) SB_STORE(1, kO, vO);
        __syncthreads();
        if (c >= 1) {
            if (c >= 3) SB_LOAD(c - 3, kO, vO);
            SB_COMPUTE(c - 1, 1);
            if (c >= 2) SB_STORE(0, kE, vE);
            __syncthreads();
        }
    }
#undef SB_LOAD
#undef SB_LOADC
#undef SB_STORE
#undef SB_COMPUTE
    bf16_t* Ow = O + ((size_t)b * SEQ + (t0 - NMETA)) * DM + h * 64 + r32;
#pragma unroll
    for (int r = 0; r < 16; ++r) { const int q = (r & 3) + 8 * (r >> 2) + 4 * hi;
        Ow[(size_t)q * DM] = (bf16_t)(cvtpk(o0[r], 0.f) & 0xffffu); Ow[(size_t)q * DM + 32] = (bf16_t)(cvtpk(o1[r], 0.f) & 0xffffu); }
}
}

__device__ __forceinline__ unsigned f2bf(float f) { unsigned u = __builtin_bit_cast(unsigned, f); return (u + 0x7fffu + ((u >> 16) & 1u)) >> 16; }
__device__ __forceinline__ unsigned pk2(float lo, float hi) { return f2bf(lo) | (f2bf(hi) << 16); }
__device__ __forceinline__ float wave_sum(float v) {
#pragma unroll
    for (int o = 1; o < 64; o <<= 1) v += __shfl_xor(v, o);
    return v;
}
__device__ __forceinline__ int map_win(int s) {
    if (s < 1024) return s;
    if (s < 2048) { const int c = s - 1024; return 1024 + (c >> 7) * 256 + (c & 127); }
    if (s < 3072) { const int c = s - 2048; return 1024 + (c >> 7) * 256 + 128 + (c & 127); }
    if (s < 5120) { const int base = s < 4096 ? 3072 : 4096, c = s - base, hh = c >> 6, d = c & 63; return base + (hh >> 2) * 256 + (d >> 5) * 128 + (hh & 3) * 32 + (d & 31); }
    if (s >= 6144) { const int c = s - 6144, br = c >> 10, ch = c & 1023; return 6144 + (ch >> 7) * 256 + br * 128 + (ch & 127); }
    return s;
}
__device__ __forceinline__ int map_wfi(int s) { const int up = s >= DFF, j = up ? s - DFF : s; return (j >> 7) * 256 + up * 128 + (j & 127); }
__device__ __forceinline__ void p0_transpose_item(const float* W, int K, int N, bf16_t* WT, int k0, int n0, int drow0, const float* gain, LAS float* scr, int lane) {
    float tv[32];
#pragma unroll
    for (int i = 0; i < 32; ++i) tv[i] = __builtin_nontemporal_load(W + (size_t)(k0 + 2 * i + (lane >> 5)) * N + n0 + (lane & 31));
    if (gain) {
#pragma unroll
        for (int i = 0; i < 32; ++i) tv[i] *= gain[k0 + 2 * i + (lane >> 5)]; }
#pragma unroll
    for (int i = 0; i < 32; ++i) scr[(2 * i + (lane >> 5)) * 33 + (lane & 31)] = tv[i];
    asm volatile("s_waitcnt lgkmcnt(0)" ::: "memory");
    const int c = lane & 7;
#pragma unroll
    for (int j = 0; j < 4; ++j) { const int n = (lane >> 3) + 8 * j; const LAS float* s = scr + (8 * c) * 33 + n;
        u32x4 o; o.x = pk2(s[0 * 33], s[1 * 33]); o.y = pk2(s[2 * 33], s[3 * 33]); o.z = pk2(s[4 * 33], s[5 * 33]); o.w = pk2(s[6 * 33], s[7 * 33]);
        *(u32x4*)(WT + (size_t)(drow0 + n) * K + k0 + 8 * c) = o; }
    asm volatile("s_waitcnt lgkmcnt(0)" ::: "memory");
}

#define XB_TMO      128
#define XB_XCNT(j)  (256  + 64 * (j))
#define XB_XSUB(j)  (1280 + 64 * (j))
#define XB_XGEN(j)  (2304 + 64 * (j))
#define XB_TOP      3328
#define XB_TOPGEN   3392
#define XCD_BAR_WORDS 3456
#define XB_SPIN_CAP (1u << 20)
__device__ __forceinline__ unsigned xb_ld(unsigned* p)              { return __hip_atomic_load(p, __ATOMIC_RELAXED, __HIP_MEMORY_SCOPE_AGENT); }
__device__ __forceinline__ unsigned xb_add(unsigned* p, unsigned v) { return __hip_atomic_fetch_add(p, v, __ATOMIC_RELAXED, __HIP_MEMORY_SCOPE_AGENT); }
__device__ __forceinline__ unsigned xb_xcc_id() { return (unsigned)__builtin_amdgcn_s_getreg((3 << 11) | 20) & 0xFu; }
#define XB_SPIN(cond, bar) do { unsigned _sp = 0; while (cond) { __builtin_amdgcn_s_sleep(1); \
    if ((++_sp & 255u) == 0u) { if (xb_ld(&(bar)[XB_TMO])) break; if (_sp > XB_SPIN_CAP) { atomicAdd(&(bar)[XB_TMO], 1u); break; } } } } while (0)
struct XcdBarrier { unsigned* bar; unsigned x; volatile LAS unsigned* st; };
__device__ __forceinline__ XcdBarrier xcd_barrier_post(unsigned* bar, volatile LAS unsigned* st) {
    XcdBarrier b; b.bar = bar; b.x = xb_xcc_id(); b.st = st;
    if (threadIdx.x == 0) (void)xb_add(&bar[XB_XCNT(b.x)], 1u);
    return b;
}
__device__ __forceinline__ void xcd_barrier_complete(unsigned* bar, unsigned x, unsigned& nloc, unsigned& nx) {
    const unsigned G = gridDim.x * gridDim.y * gridDim.z;
    unsigned sum, cnt, mine, sp = 0u;
    for (;;) {
        sum = 0u; cnt = 0u; mine = 0u;
#pragma unroll
        for (unsigned j = 0; j < 16; ++j) { const unsigned c = xb_ld(&bar[XB_XCNT(j)]); sum += c; cnt += (c > 0u) ? 1u : 0u; mine = (j == x) ? c : mine; }
        if (sum == G) break;
        __builtin_amdgcn_s_sleep(1);
        if ((++sp & 255u) == 0u) { if (xb_ld(&bar[XB_TMO])) break; if (sp > XB_SPIN_CAP) { atomicAdd(&bar[XB_TMO], 1u); break; } }
    }
    nloc = mine > 0u ? mine : 1u; nx = cnt > 0u ? cnt : 1u;
}
__device__ __forceinline__ void xcd_barrier(const XcdBarrier& b) {
    asm volatile("s_waitcnt vmcnt(0)" ::: "memory");
    __syncthreads();
    if (threadIdx.x == 0) {
        unsigned* bar = b.bar;
        __builtin_amdgcn_s_waitcnt(0);
        unsigned nloc = b.st[0], nx = b.st[1];
        if (nloc == 0u) { xcd_barrier_complete(bar, b.x, nloc, nx); b.st[0] = nloc; b.st[1] = nx; }
        const unsigned old = xb_add(&bar[XB_XSUB(b.x)], 1u);
        const unsigned gen = old / nloc;
        if (old + 1u == (gen + 1u) * nloc) {
            __builtin_amdgcn_fence(__ATOMIC_RELEASE, "agent");
            asm volatile("s_waitcnt vmcnt(0)" ::: "memory");
            const unsigned og = xb_add(&bar[XB_TOP], 1u);
            const unsigned tg = og / nx;
            if (og + 1u == (tg + 1u) * nx) xb_add(&bar[XB_TOPGEN], 1u);
            else XB_SPIN(xb_ld(&bar[XB_TOPGEN]) == tg, bar);
            __builtin_amdgcn_fence(__ATOMIC_ACQUIRE, "agent");
            xb_add(&bar[XB_XGEN(b.x)], 1u);
            asm volatile("s_waitcnt vmcnt(0)" ::: "memory");
        } else {
            XB_SPIN(xb_ld(&bar[XB_XGEN(b.x)]) == gen, bar);
            __builtin_amdgcn_fence(__ATOMIC_ACQUIRE, "agent");
            asm volatile("s_waitcnt vmcnt(0)" ::: "memory");
        }
    }
    __syncthreads();
}

__device__ __forceinline__ void stagger(int ticks) {
    const int pos = (blockIdx.x >> 3) & 31; const unsigned long long dt = (unsigned long long)((pos * ticks) >> 5);
    const unsigned long long t0 = __builtin_amdgcn_s_memrealtime();
    while (__builtin_amdgcn_s_memrealtime() - t0 < dt) __builtin_amdgcn_s_sleep(8);
}
struct Args { const float* in[14]; float* out; unsigned char* ws; int ph_lo, ph_hi; };
constexpr int NWAVES = 8, LDS_BYTES = 147456, N_PHASES = 7;
constexpr int STAG_P1 = 0, STAG_P3 = 0, STAG_P4 = 0, STAG_P5 = 0, STAG_P6 = 0;

__global__ void __launch_bounds__(NWAVES * 64, 2) fwd_megakernel(Args args) {
    extern __shared__ __attribute__((aligned(16))) unsigned char lds_raw[];
    LAS unsigned char* lds = (LAS unsigned char*)lds_raw;
    cg::grid_group grid = cg::this_grid();
    const int tid = threadIdx.x, lane = tid & 63, wave = __builtin_amdgcn_readfirstlane(tid >> 6);
    const int G = gridDim.x, bx = blockIdx.x;
    const int vcu = (G % 8 == 0) ? (bx % 8) * (G / 8) + bx / 8 : bx;
    unsigned char* ws = args.ws; unsigned char* ob = (unsigned char*)args.out;
    const float* x = args.in[0]; const float* meta = args.in[1]; const float* norm1_g = args.in[2]; const float* w_in = args.in[3]; const float* b_gate = args.in[4];
    const float* conv_w = args.in[5]; const float* w_conv_out = args.in[6]; const float* q_norm_g = args.in[7]; const float* k_norm_g = args.in[8]; const float* w_sb_out = args.in[9];
    const float* w_o = args.in[10]; const float* norm2_g = args.in[11]; const float* w_ffn_in = args.in[12]; const float* w_ffn_out = args.in[13];
    float* SSQ = (float*)(ws + WS_SSQ);
    bf16_t* WIN = (bf16_t*)(ws + WS_WIN); bf16_t* WC = (bf16_t*)(ws + WS_WC); bf16_t* WSB = (bf16_t*)(ws + WS_WS); bf16_t* WO = (bf16_t*)(ws + WS_WO);
    bf16_t* WFI = (bf16_t*)(ws + WS_WFI); bf16_t* WFO = (bf16_t*)(ws + WS_WFO);
    bf16_t* XB = (bf16_t*)(ws + WS_XB); bf16_t* CU = (bf16_t*)(ws + WS_CU); bf16_t* Qb = (bf16_t*)(ws + WS_Q); bf16_t* Kb = (bf16_t*)(ws + WS_K); bf16_t* Vb = (bf16_t*)(ws + WS_V);
    bf16_t* Gb = (bf16_t*)(ws + WS_G); bf16_t* Tb = (bf16_t*)(ws + WS_T); bf16_t* MMb = (bf16_t*)(ws + WS_MM); bf16_t* H1B = (bf16_t*)(ws + WS_H1B); bf16_t* ACT = (bf16_t*)(ws + WS_ACT);
    bf16_t* HB = (bf16_t*)ob; bf16_t* Ub = (bf16_t*)(ob + OUT_U); bf16_t* Ob = (bf16_t*)(ob + OUT_O);
    const int lo = args.ph_lo, hi = args.ph_hi;
#define IN(k) (lo <= (k) && (k) < hi)
#define SEAM(k) do { if (IN(k) && IN((k) + 1)) xcd_barrier(xbar); } while (0)
    volatile LAS unsigned* xst = (volatile LAS unsigned*)(lds + 143360);
    if (tid == 0) { xst[0] = 0u; xst[1] = 0u; }
    __syncthreads();
    const XcdBarrier xbar = xcd_barrier_post((unsigned*)(ws + WS_BAR), xst);

    if (IN(0)) {
        LAS float* scr = (LAS float*)(lds + wave * 16384);
        const int gw = vcu * NWAVES + wave, NGW = G * NWAVES;
        constexpr int I_IN = 16 * (NIN / 32);
        for (int it = gw; it < I_IN; it += NGW) { const int nblk = NIN / 32, kb = it / nblk, nb = it % nblk; p0_transpose_item(w_in, DM, NIN, WIN, 64 * kb, 32 * nb, map_win(32 * nb), norm1_g, scr, lane); }
        for (int m = gw; m < MFULL; m += 2 * NGW) {
            const int m2 = m + NGW; const bool two = m2 < MFULL; const int mb = two ? m2 : m;
            const int b1 = m / LTOK, t1 = m % LTOK, b2 = mb / LTOK, t2 = mb % LTOK;
            const float* s1 = t1 < NMETA ? meta + (size_t)t1 * DM : x + ((size_t)b1 * SEQ + (t1 - NMETA)) * DM;
            const float* s2 = t2 < NMETA ? meta + (size_t)t2 * DM : x + ((size_t)b2 * SEQ + (t2 - NMETA)) * DM;
            const f32x4* xr1 = (const f32x4*)s1 + lane; const f32x4* xr2 = (const f32x4*)s2 + lane; f32x4 v[4], w[4]; float sa = 0.f, sb2 = 0.f;
#pragma unroll
            for (int j = 0; j < 4; ++j) { v[j] = __builtin_nontemporal_load(xr1 + 64 * j); w[j] = __builtin_nontemporal_load(xr2 + 64 * j); }
#pragma unroll
            for (int j = 0; j < 4; ++j) { sa += (v[j].x * v[j].x + v[j].y * v[j].y) + (v[j].z * v[j].z + v[j].w * v[j].w); sb2 += (w[j].x * w[j].x + w[j].y * w[j].y) + (w[j].z * w[j].z + w[j].w * w[j].w); }
            const float ra = 1.0f / sqrtf(wave_sum(sa) * (1.0f / DM) + EPS), rb = 1.0f / sqrtf(wave_sum(sb2) * (1.0f / DM) + EPS);
            u32x2* o1 = (u32x2*)(HB + (size_t)m * DM) + lane; u32x2* o2 = (u32x2*)(HB + (size_t)mb * DM) + lane;
#pragma unroll
            for (int j = 0; j < 4; ++j) o1[64 * j] = (u32x2){pk2(v[j].x * ra, v[j].y * ra), pk2(v[j].z * ra, v[j].w * ra)};
            if (two) {
#pragma unroll
                for (int j = 0; j < 4; ++j) o2[64 * j] = (u32x2){pk2(w[j].x * rb, w[j].y * rb), pk2(w[j].z * rb, w[j].w * rb)}; }
        }
        for (int i = bx * (NWAVES * 64) + tid; i < MC; i += G * NWAVES * 64) SSQ[i] = 0.f;
    }
    SEAM(0);

    if (IN(1)) {
        pg8::Gemm g{HB, WIN, MFULL, NIN, DM, HB, WIN, DM}; pg8::StaticOrder S; S.init(MFULL, NIN, G, bx);
        LAS float* cst = (LAS float*)(lds + pg8::STAGE_BYTES);
        for (int i = tid; i < 128 + 2048; i += NWAVES * 64) cst[i] = i < 64 ? q_norm_g[i] : (i < 128 ? k_norm_g[i - 64] : b_gate[i - 128]);
        __syncthreads();
        pg8::EpiP1 E{XB, CU, Qb, Kb, Vb, Gb, cst};
        pg8::gemm_phase<pg8::EpiP1, pg8::StaticOrder, true, true>(lds, g, S, E);
        const int NLAST = ((MFULL / 256) * (NIN / 256)) % G;
        if (bx >= NLAST) {
            LAS float* scr = (LAS float*)(lds + wave * 16384);
            const int gw2 = (bx - NLAST) * NWAVES + wave, NGW2 = (G - NLAST) * NWAVES;
            constexpr int I_SQ = 16 * 32, I_FI = 16 * (NFF2 / 32), I_FO = (DFF / 64) * 32, NIT = 3 * I_SQ + I_FI + I_FO;
            for (int it = gw2; it < NIT; it += NGW2) {
                int r = it;
                if (r < 3 * I_SQ) { const int w = r / I_SQ, rr = r % I_SQ, kb = rr / 32, nb = rr % 32; const float* W = w == 0 ? w_conv_out : (w == 1 ? w_sb_out : w_o); bf16_t* WT = w == 0 ? WC : (w == 1 ? WSB : WO);
                    p0_transpose_item(W, DM, DM, WT, 64 * kb, 32 * nb, 32 * nb, nullptr, scr, lane); continue; } r -= 3 * I_SQ;
                if (r < I_FI) { const int nblk = NFF2 / 32, kb = r / nblk, nb = r % nblk; p0_transpose_item(w_ffn_in, DM, NFF2, WFI, 64 * kb, 32 * nb, map_wfi(32 * nb), norm2_g, scr, lane); continue; } r -= I_FI;
                { const int kb = r / 32, nb = r % 32; p0_transpose_item(w_ffn_out, DFF, DM, WFO, 64 * kb, 32 * nb, 32 * nb, nullptr, scr, lane); }
            }
        }
    }
    SEAM(1);

    if (IN(2)) {
        for (int p = vcu; p < NB * 16; p += G)
            for (int j = 7; j >= 0; --j) sb::attn_unit(p >> 4, p & 15, j, Qb, Kb, Vb, Ob, lds);
        for (int item = bx * (NWAVES * 64) + tid; item < (MC / 16) * 128; item += G * NWAVES * 64) {
            const int c0 = (item & 127) * 8, crow0 = (item >> 7) * 16; const int m0 = crow0 + ((crow0 >> 11) + 1) * NMETA;
            f32x4 w0a = *(const f32x4*)(conv_w + c0), w0b = *(const f32x4*)(conv_w + c0 + 4), w1a = *(const f32x4*)(conv_w + DM + c0), w1b = *(const f32x4*)(conv_w + DM + c0 + 4),
                  w2a = *(const f32x4*)(conv_w + 2 * DM + c0), w2b = *(const f32x4*)(conv_w + 2 * DM + c0 + 4);
            f32x4 p2a, p2b, p1a, p1b;
            pg8::unpack8(*(const u32x4*)(CU + (size_t)(m0 - 2) * DM + c0), p2a, p2b); pg8::unpack8(*(const u32x4*)(CU + (size_t)(m0 - 1) * DM + c0), p1a, p1b);
#pragma unroll 4
            for (int i = 0; i < 16; ++i) { f32x4 ca, cb, xa, xbv;
                pg8::unpack8(*(const u32x4*)(CU + (size_t)(m0 + i) * DM + c0), ca, cb); pg8::unpack8(*(const u32x4*)(XB + (size_t)(m0 + i) * DM + c0), xa, xbv);
                const f32x4 ua = xa * (w0a * p2a + w1a * p1a + w2a * ca), ub = xbv * (w0b * p2b + w1b * p1b + w2b * cb);
                *(u32x4*)(Ub + (size_t)(crow0 + i) * DM + c0) = pg8::pack8(ua, ub);
                p2a = p1a; p2b = p1b; p1a = ca; p1b = cb; }
        }
    }
    SEAM(2);

    if (IN(3)) {
        pg8::StaticOrder S; S.init(MC, DM, G, bx);
        pg8::Gemm g{Ub, WC, MC, DM, 2 * DM, Ob, WSB, DM}; pg8::EpiMerged E{Gb, MMb};
        pg8::gemm_phase<pg8::EpiMerged, pg8::StaticOrder, true, true>(lds, g, S, E);
    }
    SEAM(3);

    if (IN(4)) {
        pg8::Gemm g{MMb, WO, MC, DM, DM, MMb, WO, DM}; pg8::StaticOrder S; S.init(MC, DM, G, bx);
        pg8::EpiH1 E{x, H1B, SSQ};
        pg8::gemm_phase<pg8::EpiH1, pg8::StaticOrder, true, true>(lds, g, S, E);
    }
    SEAM(4);

    if (IN(5)) {
        pg8::Gemm g{H1B, WFI, MC, NFF2, DM, H1B, WFI, DM}; pg8::StaticOrder S; S.init(MC, NFF2, G, bx);
        pg8::EpiF1 E{SSQ, ACT, (LAS float*)(lds + pg8::STAGE_BYTES)};
        pg8::gemm_phase<pg8::EpiF1, pg8::StaticOrder, true, true>(lds, g, S, E);
    }
    SEAM(5);

    if (IN(6)) {
        pg8::Gemm g{ACT, WFO, MC, DM, DFF, ACT, WFO, DFF}; pg8::StaticOrder S; S.init(MC, DM, G, bx);
        pg8::EpiOut E{H1B, args.out};
        pg8::gemm_phase<pg8::EpiOut, pg8::StaticOrder, true, true>(lds, g, S, E);
    }
    if (lo < 0) grid.sync();
#undef IN
#undef SEAM
}

extern "C" void kernel_launch(void* const* d_in, const int* in_sizes, int n_in, void* d_out, int out_size, void* d_ws, size_t ws_size, hipStream_t stream) {
    static int grid = 0;
    if (grid == 0) {
        if (n_in != 14 || out_size != MC * DM || ws_size < WS_END) { fprintf(stderr, "kernel_launch: unexpected shapes (n_in %d, out %d, ws %zu < %zu)\n", n_in, out_size, ws_size, (size_t)WS_END); grid = -1; return; }
        int dev = 0, cus = 0, per_cu = 0;
        hipGetDevice(&dev); hipDeviceGetAttribute(&cus, hipDeviceAttributeMultiprocessorCount, dev);
        if (hipFuncSetAttribute((const void*)fwd_megakernel, hipFuncAttributeMaxDynamicSharedMemorySize, LDS_BYTES) != hipSuccess) { fprintf(stderr, "kernel_launch: hipFuncSetAttribute failed\n"); grid = -1; return; }
        if (hipOccupancyMaxActiveBlocksPerMultiprocessor(&per_cu, (const void*)fwd_megakernel, NWAVES * 64, LDS_BYTES) != hipSuccess || per_cu < 1) { fprintf(stderr, "kernel_launch: occupancy query says %d\n", per_cu); per_cu = 1; }
        (void)hipGetLastError();
        grid = cus * 1;
    }
    if (grid < 0) return;
    if (hipMemsetAsync((char*)d_ws + WS_BAR, 0, 16384, stream) != hipSuccess) { fprintf(stderr, "kernel_launch: memset of the barrier words failed\n"); return; }
    Args a{};
    for (int i = 0; i < 14; ++i) a.in[i] = (const float*)d_in[i];
    a.out = (float*)d_out; a.ws = (unsigned char*)d_ws;
#if MK_N_LAUNCHES == 1
    a.ph_lo = 0; a.ph_hi = N_PHASES;
    void* kargs[] = {&a};
    hipError_t e = hipLaunchCooperativeKernel((const void*)fwd_megakernel, dim3(grid), dim3(NWAVES * 64), kargs, LDS_BYTES, stream);
    if (e != hipSuccess) fprintf(stderr, "kernel_launch: cooperative launch failed: %s (grid %d)\n", hipGetErrorString(e), grid);
#else
    for (int p = 0; p < N_PHASES; ++p) { a.ph_lo = p; a.ph_hi = p + 1; hipLaunchKernelGGL(fwd_megakernel, dim3(grid), dim3(NWAVES * 64), LDS_BYTES, stream, a); }
#endif
}
```
